# Optimizing an MI355X kernel written in HIP

```python
import jax, jax.numpy as jnp
from jax import lax
import numpy as np

D_MODEL = 2048
BATCH = 8
SEQ = 2048
DEPTH = 2
DEC_BATCH = 128
DEC_SEQ = 4
PAST_LEN = 8192
PAGE_SIZE = 128

HEAD_DIM = 64
ATT_WIDTH = D_MODEL // 2
ATT_HEADS = ATT_WIDTH // HEAD_DIM
KV_HEADS = ATT_HEADS // 8
GROUP = ATT_HEADS // KV_HEADS
KV_WIDTH = KV_HEADS * HEAD_DIM
WINDOW = 128
BLOCK = 128
SGU_WIDTH = D_MODEL - ATT_WIDTH
SGU_HEADS = 8
SGU_HEAD_DIM = SGU_WIDTH // SGU_HEADS
CHUNK = 128
MIX_WIDTH = ATT_WIDTH + SGU_WIDTH
IN_COLS = ATT_WIDTH + 2 * KV_WIDTH + 2 * SGU_WIDTH
D_FF = 5504
CONV_W = 3
EPS = 1e-6
NEG_INF = -1e30

kernel_name = 'hymba_swa_sink_sgu_convffn_step'


def _rms(x, g):
    xf = x.astype(jnp.float32)
    y = xf * lax.rsqrt(jnp.mean(xf * xf, axis=-1, keepdims=True) + EPS)
    return (y * g.astype(jnp.float32)).astype(x.dtype)


def _layernorm(x, g, b):
    xf = x.astype(jnp.float32)
    mu = jnp.mean(xf, axis=-1, keepdims=True)
    xc = xf - mu
    y = xc * lax.rsqrt(jnp.mean(xc * xc, axis=-1, keepdims=True) + EPS)
    return (y * g.astype(jnp.float32) + b.astype(jnp.float32)).astype(x.dtype)


def _alibi_slopes():
    h = jnp.arange(1, ATT_HEADS + 1, dtype=jnp.float32)
    return jnp.exp2(-8.0 * h / ATT_HEADS).reshape(KV_HEADS, GROUP)


def _project(xn, w_in, g_q, g_k, ln_g, ln_b):
    z = xn @ w_in
    lead = z.shape[:-1]
    c1 = ATT_WIDTH
    c2 = c1 + KV_WIDTH
    c3 = c2 + KV_WIDTH
    c4 = c3 + SGU_WIDTH
    q = _rms(z[..., :c1].reshape(lead + (ATT_HEADS, HEAD_DIM)), g_q)
    k = _rms(z[..., c1:c2].reshape(lead + (KV_HEADS, HEAD_DIM)), g_k)
    v = z[..., c2:c3].reshape(lead + (KV_HEADS, HEAD_DIM))
    u = jax.nn.gelu(z[..., c3:c4])
    vs = _layernorm(jax.nn.gelu(z[..., c4:]), ln_g, ln_b).reshape(lead + (SGU_HEADS, SGU_HEAD_DIM))
    return q, k, v, u, vs


def _band_attention(q, k, v, q_pos, k_pos, sinks):
    B, N, Tq = q.shape[:3]
    qg = q.reshape(B, N, Tq, KV_HEADS, GROUP, HEAD_DIM)
    s = jnp.einsum('bnqkgd,bnskd->bnkgqs', qg, k,
                   preferred_element_type=jnp.float32) * (HEAD_DIM ** -0.5)
    dist = q_pos[:, :, None] - k_pos[:, None, :]
    valid = (dist >= 0) & (dist < WINDOW) & (k_pos[:, None, :] >= 0)
    slopes = _alibi_slopes()[None, None, :, :, None, None]
    s = s - slopes * dist.astype(jnp.float32)[None, :, None, None]
    s = jnp.where(valid[None, :, None, None], s, NEG_INF)
    sink = jnp.broadcast_to(
        sinks.astype(jnp.float32).reshape(KV_HEADS, GROUP)[None, None, :, :, None, None],
        s.shape[:-1] + (1,))
    p = jax.nn.softmax(jnp.concatenate([s, sink], axis=-1), axis=-1)[..., :-1]
    o = jnp.einsum('bnkgqs,bnskd->bnqkgd', p.astype(v.dtype), v)
    return o.reshape(B, N, Tq, ATT_WIDTH)


def _sgu(u, vs, w_s, b_s):
    T = u.shape[2]
    w = jnp.tril(w_s)[:, :T, :T]
    mixed = jnp.einsum('hts,bcshe->bcthe', w.astype(vs.dtype), vs) + b_s[:, :T].T[:, :, None]
    return u * mixed


def _merge(att, sgu, g_oa, g_os, w_o):
    return jnp.concatenate([_rms(att, g_oa), _rms(sgu, g_os)], axis=-1) @ w_o


def _conv_ffn(xn, buf, w_up, conv_w, conv_b, w_down):
    h = xn @ w_up
    T = h.shape[1]
    hp = jnp.concatenate([buf.astype(h.dtype), h], axis=1)
    hc = conv_b + conv_w[0] * hp[:, 0:T]
    for j in range(1, CONV_W):
        hc = hc + conv_w[j] * hp[:, j:j + T]
    a, g = jnp.split(hc, 2, axis=-1)
    return (jax.nn.silu(g) * a) @ w_down, hp[:, -(CONV_W - 1):]


def _prompt_layer(x, p):
    (g_mix, w_in, g_q, g_k, sinks, ln_g, ln_b, w_s, b_s,
     g_oa, g_os, w_o, g_ffn, w_up, conv_w, conv_b, w_down) = p
    B, S, _ = x.shape
    nb = S // BLOCK
    q, k, v, u, vs = _project(_rms(x, g_mix), w_in, g_q, g_k, ln_g, ln_b)
    qb = q.reshape(B, nb, BLOCK, ATT_HEADS, HEAD_DIM)
    kb = k.reshape(B, nb, BLOCK, KV_HEADS, HEAD_DIM)
    vb = v.reshape(B, nb, BLOCK, KV_HEADS, HEAD_DIM)

    def band(t):
        prev = jnp.pad(t, ((0, 0), (1, 0), (0, 0), (0, 0), (0, 0)))[:, :-1]
        return jnp.concatenate([prev, t], axis=2)

    pos = jnp.arange(S, dtype=jnp.int32).reshape(nb, BLOCK)
    k_pos = jnp.concatenate([pos - BLOCK, pos], axis=-1)
    att = _band_attention(qb, band(kb), band(vb), pos, k_pos, sinks).reshape(B, S, ATT_WIDTH)
    nc = S // CHUNK
    sgu = _sgu(u.reshape(B, nc, CHUNK, SGU_HEADS, SGU_HEAD_DIM),
               vs.reshape(B, nc, CHUNK, SGU_HEADS, SGU_HEAD_DIM), w_s, b_s).reshape(B, S, SGU_WIDTH)
    x = x + _merge(att, sgu, g_oa, g_os, w_o)
    zero_buf = jnp.zeros((B, CONV_W - 1, 2 * D_FF), x.dtype)
    y, conv_state = _conv_ffn(_rms(x, g_ffn), zero_buf, w_up, conv_w, conv_b, w_down)
    return x + y, k[:, -WINDOW:], v[:, -WINDOW:], conv_state


def _sample_layer(x, k_buf, v_buf, conv_buf, p):
    (g_mix, w_in, g_q, g_k, sinks, ln_g, ln_b, w_s, b_s,
     g_oa, g_os, w_o, g_ffn, w_up, conv_w, conv_b, w_down) = p
    Bd, T, _ = x.shape
    q, k, v, u, vs = _project(_rms(x, g_mix), w_in, g_q, g_k, ln_g, ln_b)
    kc = jnp.concatenate([k_buf.astype(k.dtype), k], axis=1)
    vc = jnp.concatenate([v_buf.astype(v.dtype), v], axis=1)
    q_pos = (PAST_LEN + jnp.arange(T, dtype=jnp.int32))[None]
    k_pos = (PAST_LEN - WINDOW + jnp.arange(WINDOW + T, dtype=jnp.int32))[None]
    att = _band_attention(q[:, None], kc[:, None], vc[:, None], q_pos, k_pos, sinks).reshape(Bd, T, ATT_WIDTH)
    sgu = _sgu(u.reshape(Bd, 1, T, SGU_HEADS, SGU_HEAD_DIM), vs[:, None], w_s, b_s).reshape(Bd, T, SGU_WIDTH)
    x = x + _merge(att, sgu, g_oa, g_os, w_o)
    y, conv_state = _conv_ffn(_rms(x, g_ffn), conv_buf, w_up, conv_w, conv_b, w_down)
    return x + y, kc[:, -WINDOW:], vc[:, -WINDOW:], conv_state, vs


def setup_inputs(seed: int = 0) -> dict:
    key = jax.random.key(seed)
    ks = jax.random.split(key, 24)
    f32 = jnp.float32
    nrm = lambda k, shape, scale: jax.random.normal(k, shape, f32) * scale
    gain = lambda k, shape: 1.0 + 0.02 * jax.random.normal(k, shape, f32)
    return {
        'x_prompt': nrm(ks[0], (BATCH, SEQ, D_MODEL), 1.0),
        'x_sample': nrm(ks[1], (DEC_BATCH, DEC_SEQ, D_MODEL), 1.0),
        'cache_k_win': nrm(ks[2], (DEPTH, DEC_BATCH, WINDOW, KV_HEADS, HEAD_DIM), 1.0),
        'cache_v_win': nrm(ks[3], (DEPTH, DEC_BATCH, WINDOW, KV_HEADS, HEAD_DIM), 1.0),
        'state_ffn_conv': nrm(ks[4], (DEPTH, DEC_BATCH, CONV_W - 1, 2 * D_FF), 1.0),
        'norm_mix_g': gain(ks[5], (DEPTH, D_MODEL)),
        'w_in': nrm(ks[6], (DEPTH, D_MODEL, IN_COLS), D_MODEL ** -0.5),
        'q_norm_g': gain(ks[7], (DEPTH, HEAD_DIM)),
        'k_norm_g': gain(ks[8], (DEPTH, HEAD_DIM)),
        'attn_sinks': nrm(ks[9], (DEPTH, ATT_HEADS), 0.5),
        'sgu_ln_g': gain(ks[10], (DEPTH, SGU_WIDTH)),
        'sgu_ln_b': nrm(ks[11], (DEPTH, SGU_WIDTH), 0.02),
        'sgu_w': nrm(ks[12], (DEPTH, SGU_HEADS, CHUNK, CHUNK), CHUNK ** -0.5),
        'sgu_b': gain(ks[13], (DEPTH, SGU_HEADS, CHUNK)),
        'out_norm_att_g': gain(ks[14], (DEPTH, ATT_WIDTH)),
        'out_norm_sgu_g': gain(ks[15], (DEPTH, SGU_WIDTH)),
        'w_o': nrm(ks[16], (DEPTH, MIX_WIDTH, D_MODEL), 0.5 * MIX_WIDTH ** -0.5),
        'norm_ffn_g': gain(ks[17], (DEPTH, D_MODEL)),
        'w_up': nrm(ks[18], (DEPTH, D_MODEL, 2 * D_FF), D_MODEL ** -0.5),
        'conv_w': nrm(ks[19], (DEPTH, CONV_W, 2 * D_FF), CONV_W ** -0.5),
        'conv_b': nrm(ks[20], (DEPTH, 2 * D_FF), 0.02),
        'w_down': nrm(ks[21], (DEPTH, D_FF, D_MODEL), 0.5 * D_FF ** -0.5),
    }


def reference(x_prompt, x_sample, cache_k_win, cache_v_win, state_ffn_conv,
              norm_mix_g, w_in, q_norm_g, k_norm_g, attn_sinks, sgu_ln_g, sgu_ln_b,
              sgu_w, sgu_b, out_norm_att_g, out_norm_sgu_g, w_o, norm_ffn_g,
              w_up, conv_w, conv_b, w_down):
    xp, xs = x_prompt, x_sample
    kp_l, vp_l, cp_l, ks_l, vs_l, cs_l, sv_l = [], [], [], [], [], [], []
    for l in range(DEPTH):
        p = (norm_mix_g[l], w_in[l], q_norm_g[l], k_norm_g[l], attn_sinks[l], sgu_ln_g[l],
             sgu_ln_b[l], sgu_w[l], sgu_b[l], out_norm_att_g[l], out_norm_sgu_g[l], w_o[l],
             norm_ffn_g[l], w_up[l], conv_w[l], conv_b[l], w_down[l])
        xp, kp, vp, cp = _prompt_layer(xp, p)
        xs, kn, vn, cn, svn = _sample_layer(xs, cache_k_win[l], cache_v_win[l], state_ffn_conv[l], p)
        kp_l.append(kp); vp_l.append(vp); cp_l.append(cp)
        ks_l.append(kn); vs_l.append(vn); cs_l.append(cn); sv_l.append(svn)
    k_win_prompt = jnp.stack(kp_l)
    v_win_prompt = jnp.stack(vp_l)
    ffn_conv_prompt = jnp.stack(cp_l)
    k_win_sample = jnp.stack(ks_l)
    v_win_sample = jnp.stack(vs_l)
    ffn_conv_sample = jnp.stack(cs_l)
    sgu_v_sample = jnp.stack(sv_l)
    return (xp, xs, k_win_prompt, v_win_prompt, ffn_conv_prompt,
            k_win_sample, v_win_sample, ffn_conv_sample, sgu_v_sample)
```

```cpp
#include <hip/hip_runtime.h>
#include <hip/hip_cooperative_groups.h>
#include <cstdio>
#include <cstdint>
namespace cg = cooperative_groups;
#define MK_DUP 0
#define MK_MIXDUP 0
namespace pg8 {
#define PG8_LAS __attribute__((address_space(3)))
typedef unsigned short bf16_t;
typedef short bf16x8 __attribute__((ext_vector_type(8)));
typedef float f32x4 __attribute__((ext_vector_type(4)));
typedef unsigned u32x4 __attribute__((ext_vector_type(4)));
constexpr int BM = 256, BK = 64, HALF = 128, HTB = HALF * BK * 2  , STAGE_BYTES = 8 * HTB, NXCD = 8, WGM = 8;

__host__ __device__ __forceinline__ int lds_byte(int r, int c) { const int st = (r >> 4) * 2 + (c >> 5), rr = r & 15, cc = c & 31, ob = rr * 64 + cc * 2; return st * 1024 + (ob ^ (((ob >> 9) & 1) << 5)); }
__host__ __device__ __forceinline__ void stage_rc(int b, int& R, int& C) { const int st = b / 1024, sb = b % 1024, swz = sb ^ (((sb >> 9) & 1) << 5); R = (st >> 1) * 16 + swz / 64; C = (st & 1) * 32 + (swz % 64) / 2; }
__host__ __device__ __forceinline__ int perm32(int rho) { const int n = rho >> 4, i = rho & 15; return 8 * (i >> 2) + 4 * n + (i & 3); }

struct Unit { int pm, pn, k0, nt, sp; };
struct Gemm { const bf16_t* A; const bf16_t* Bt; int M, N, K, wave; };

struct StaticOrder {
    int nM, nN, nwg, G, c, ntK;
    __host__ __device__ void init(int M, int N, int G_, int c_, int ntK_) { nM = M / BM; nN = N / BM; nwg = nM * nN; G = G_; c = c_; ntK = ntK_; }
    __host__ __device__ bool next(int i, Unit& u) const {
        const long L = (long)i * G + c; if (L >= nwg) return false;
        int wgid = (int)L; { const int q = nwg / NXCD, r = nwg % NXCD, xcd = wgid % NXCD, off = wgid / NXCD; wgid = (xcd < r ? xcd * (q + 1) : r * (q + 1) + (xcd - r) * q) + off; }
        const int nig = WGM * nN, gid = wgid / nig, fm = gid * WGM, gsz = (nM - fm) < WGM ? (nM - fm) : WGM;
        u.pm = fm + ((wgid % nig) % gsz); u.pn = (wgid % nig) / gsz; u.k0 = 0; u.nt = ntK; u.sp = 0; return true;
    }
    __device__ __forceinline__ void a_ready(const Unit&) const {}
    __device__ __forceinline__ void done(const Unit&) const {}
};


struct SplitOrder {
    StaticOrder main; int nMmain, nMtail, nsplit;
    __host__ __device__ void init(int Mmain, int Mtail, int N, int G_, int c_, int ntK_, int nsplit_) { main.init(Mmain, N, G_, c_, ntK_); nMmain = Mmain / BM; nMtail = Mtail / BM; nsplit = nsplit_; }
    __host__ __device__ bool next(int i, Unit& u) const {
        const long L = (long)i * main.G + main.c;
        if (L < main.nwg) return main.next(i, u);
        const int j = (int)(L - main.nwg), nu = nMtail * main.nN; if (j >= nu * nsplit) return false;
        const int un = j % nu, sp = j / nu, iters = main.ntK / 2, i0 = (iters * sp) / nsplit, i1 = (iters * (sp + 1)) / nsplit;
        u.pm = nMmain + un / main.nN; u.pn = un % main.nN; u.k0 = 2 * i0; u.nt = 2 * (i1 - i0); u.sp = sp; return true;
    }
    __device__ __forceinline__ void a_ready(const Unit&) const {}
    __device__ __forceinline__ void done(const Unit&) const {}
};
template <class Epi, class Sched, bool ALIGN_EPI = false, bool SP2 = false>
__device__ __forceinline__ void gemm_phase(PG8_LAS unsigned char* lds, const Gemm g, const Sched& S, const Epi& E) {
    int tid_o = (int)__builtin_amdgcn_mbcnt_hi(~0u, __builtin_amdgcn_mbcnt_lo(~0u, 0u)); asm volatile("" : "+v"(tid_o)); tid_o += 64 * g.wave;
    const int tid = tid_o, wid = __builtin_amdgcn_readfirstlane(tid >> 6), lane = tid & 63, wr = wid >> 2, wc = wid & 3, fr = lane & 15, fq = lane >> 4;
    const int K = g.K;
    unsigned voffA[2], voffB[2];
#pragma unroll
    for (int i = 0; i < 2; ++i) { int R, C; stage_rc(tid * 16 + i * 8192, R, C); const int Rb = Epi::PERM ? ((R & ~31) + perm32(R & 31)) : R;
        const int Ra = (R & ~63) | ((R & 15) << 2) | ((R >> 4) & 3);
        voffA[i] = (unsigned)(Ra * K + C) * 2u; voffB[i] = (unsigned)(Rb * K + C) * 2u; }
    const size_t kstep = (size_t)(BK * 2);
    const size_t hstep = (size_t)HALF * K * 2;
    const size_t tstep = 2 * hstep;
    const unsigned ldsw = (unsigned)wid * 1024u;
    const int aoff = lds_byte(wr * 64 + fr, fq * 8), boff = lds_byte(wc * 32 + fr, fq * 8);
#define PG8_SA(b, h) (((b) * 2 + (h)) * HTB)
#define PG8_SB(b, h) ((4 + (b) * 2 + (h)) * HTB)
#define PG8_STAGE(bufoff, gbase, voff) do { _Pragma("unroll") for (int _i = 0; _i < 2; ++_i) \
        __builtin_amdgcn_global_load_lds((const unsigned*)((const char*)(gbase) + (voff)[_i]), (PG8_LAS unsigned*)(lds + (bufoff) + ldsw + _i * 8192), 16, 0, 0); } while (0)
#define PG8_LDA(dst, b, h) do { _Pragma("unroll") for (int m = 0; m < 4; ++m) _Pragma("unroll") for (int k = 0; k < 2; ++k) dst[m][k] = *(const PG8_LAS bf16x8*)(lds + PG8_SA(b, h) + aoff + m * 2048 + k * 1024); } while (0)
#define PG8_LDB(dst, b, h) do { _Pragma("unroll") for (int n = 0; n < 2; ++n) _Pragma("unroll") for (int k = 0; k < 2; ++k) dst[n][k] = *(const PG8_LAS bf16x8*)(lds + PG8_SB(b, h) + boff + n * 2048 + k * 1024); } while (0)
#define PG8_MMA(ai, bj, At, Bt) do { __builtin_amdgcn_s_setprio(1); _Pragma("unroll") for (int m = 0; m < 4; ++m) _Pragma("unroll") for (int n = 0; n < 2; ++n) _Pragma("unroll") for (int k = 0; k < 2; ++k) \
        acc[ai][bj][m][n] = __builtin_amdgcn_mfma_f32_16x16x32_bf16(Bt[n][k], At[m][k], acc[ai][bj][m][n], 0, 0, 0); __builtin_amdgcn_s_setprio(0); } while (0)
#define PG8_WAIT_V(n) asm volatile("s_waitcnt vmcnt(" #n ")" ::: "memory")
#define PG8_WAIT_L(n) asm volatile("s_waitcnt lgkmcnt(" #n ")" ::: "memory")
#define PG8_BAR __builtin_amdgcn_s_barrier()
#define PG8_SCHED __builtin_amdgcn_sched_barrier(0)
    Unit cur, nxt; int ui = 0;
    if (!S.next(0, cur)) return;
    f32x4 acc[2][2][4][2];
#pragma unroll
    for (int a = 0; a < 2; ++a)
#pragma unroll
        for (int b = 0; b < 2; ++b)
#pragma unroll
            for (int m = 0; m < 4; ++m)
#pragma unroll
                for (int n = 0; n < 2; ++n) acc[a][b][m][n] = (f32x4){0.f, 0.f, 0.f, 0.f};
    bf16x8 At[4][2], B0[2][2], B1[2][2];
    const char* cA = (const char*)g.A + (size_t)cur.pm * tstep + (size_t)cur.k0 * kstep; const char* cB = (const char*)g.Bt + (size_t)cur.pn * tstep + (size_t)cur.k0 * kstep;
    S.a_ready(cur);
    if constexpr (SP2) {
        PG8_STAGE(PG8_SB(0, 0), cB, voffB); PG8_STAGE(PG8_SB(0, 1), cB + hstep, voffB); PG8_STAGE(PG8_SA(0, 0), cA, voffA); PG8_STAGE(PG8_SA(0, 1), cA + hstep, voffA);
        if (wr == 1) PG8_BAR;
        PG8_WAIT_V(2); PG8_BAR;
        PG8_STAGE(PG8_SB(1, 0), cB + kstep, voffB); PG8_STAGE(PG8_SA(1, 0), cA + kstep, voffA); PG8_STAGE(PG8_SB(1, 1), cB + hstep + kstep, voffB);
        PG8_WAIT_V(6); PG8_BAR;
    } else {
        PG8_STAGE(PG8_SB(0, 0), cB, voffB); PG8_STAGE(PG8_SA(0, 0), cA, voffA); PG8_STAGE(PG8_SB(0, 1), cB + hstep, voffB); PG8_STAGE(PG8_SA(0, 1), cA + hstep, voffA);
        if (wr == 1) PG8_BAR;
        PG8_WAIT_V(4); PG8_BAR;
        PG8_STAGE(PG8_SB(1, 0), cB + kstep, voffB); PG8_STAGE(PG8_SA(1, 0), cA + kstep, voffA); PG8_STAGE(PG8_SB(1, 1), cB + hstep + kstep, voffB);
        PG8_WAIT_V(6); PG8_BAR;
    }
    for (;;) {
        const bool has_next = S.next(ui + 1, nxt);
        const char* nA = has_next ? (const char*)g.A + (size_t)nxt.pm * tstep + (size_t)nxt.k0 * kstep : cA; const char* nB = has_next ? (const char*)g.Bt + (size_t)nxt.pn * tstep + (size_t)nxt.k0 * kstep : cB;
        const int nt = cur.nt;
        for (int t = 0; t < nt; t += 2) {
            const bool last = (t == nt - 2);
            const char* a1 = cA + (size_t)(t + 1) * kstep;
            const char* a2 = last ? nA : cA + (size_t)(t + 2) * kstep; const char* b2 = last ? nB : cB + (size_t)(t + 2) * kstep;
            const char* a3 = a2 + kstep; const char* b3 = b2 + kstep;
            if (last && has_next) S.a_ready(nxt);
            if constexpr (SP2) {
            PG8_LDB(B0, 0, 0); PG8_LDB(B1, 0, 1); PG8_SCHED; PG8_LDA(At, 0, 0); PG8_STAGE(PG8_SA(1, 1), a1 + hstep, voffA);
            PG8_WAIT_V(8); PG8_WAIT_L(0); PG8_BAR; PG8_MMA(0, 0, At, B0); PG8_MMA(0, 1, At, B1); PG8_BAR; PG8_SCHED;
            PG8_LDA(At, 0, 1); PG8_STAGE(PG8_SB(0, 0), b2, voffB); PG8_STAGE(PG8_SB(0, 1), b2 + hstep, voffB); PG8_STAGE(PG8_SA(0, 0), a2, voffA);
            PG8_WAIT_V(8); PG8_WAIT_L(0); PG8_BAR; PG8_MMA(1, 0, At, B0); PG8_MMA(1, 1, At, B1); PG8_BAR; PG8_SCHED;
            PG8_LDB(B0, 1, 0); PG8_LDB(B1, 1, 1); PG8_SCHED; PG8_LDA(At, 1, 0); PG8_STAGE(PG8_SA(0, 1), a2 + hstep, voffA);
            PG8_WAIT_V(8); PG8_WAIT_L(0); PG8_BAR; PG8_MMA(0, 0, At, B0); PG8_MMA(0, 1, At, B1); PG8_BAR; PG8_SCHED;
            PG8_LDA(At, 1, 1); PG8_STAGE(PG8_SB(1, 0), b3, voffB); PG8_STAGE(PG8_SB(1, 1), b3 + hstep, voffB); PG8_STAGE(PG8_SA(1, 0), a3, voffA);
            PG8_WAIT_V(8); PG8_WAIT_L(0); PG8_BAR; PG8_MMA(1, 0, At, B0); PG8_MMA(1, 1, At, B1); PG8_BAR; PG8_SCHED;
            } else {
            PG8_LDB(B0, 0, 0); PG8_SCHED; PG8_LDA(At, 0, 0); PG8_STAGE(PG8_SA(1, 1), a1 + hstep, voffA);
            PG8_WAIT_L(8); PG8_BAR; PG8_WAIT_L(0); PG8_MMA(0, 0, At, B0); PG8_BAR; PG8_SCHED;
            PG8_LDB(B1, 0, 1); PG8_STAGE(PG8_SB(0, 0), b2, voffB);
            PG8_BAR; PG8_WAIT_L(0); PG8_MMA(0, 1, At, B1); PG8_BAR;
            PG8_LDA(At, 0, 1); PG8_STAGE(PG8_SA(0, 0), a2, voffA);
            PG8_BAR; PG8_WAIT_L(0); PG8_MMA(1, 0, At, B0); PG8_BAR; PG8_SCHED;
            PG8_STAGE(PG8_SB(0, 1), b2 + hstep, voffB);
            PG8_WAIT_V(6); PG8_BAR; PG8_MMA(1, 1, At, B1); PG8_BAR;
            PG8_LDB(B0, 1, 0); PG8_SCHED; PG8_LDA(At, 1, 0); PG8_STAGE(PG8_SA(0, 1), a2 + hstep, voffA);
            PG8_WAIT_L(8); PG8_BAR; PG8_WAIT_L(0); PG8_MMA(0, 0, At, B0); PG8_BAR; PG8_SCHED;
            PG8_LDB(B1, 1, 1); PG8_STAGE(PG8_SB(1, 0), b3, voffB);
            PG8_BAR; PG8_WAIT_L(0); PG8_MMA(0, 1, At, B1); PG8_BAR;
            PG8_LDA(At, 1, 1); PG8_STAGE(PG8_SA(1, 0), a3, voffA);
            PG8_BAR; PG8_WAIT_L(0); PG8_MMA(1, 0, At, B0); PG8_BAR; PG8_SCHED;
            PG8_STAGE(PG8_SB(1, 1), b3 + hstep, voffB);
            PG8_WAIT_V(6); PG8_BAR; PG8_MMA(1, 1, At, B1); PG8_BAR;
            }
        }
        if constexpr (ALIGN_EPI) { if (wr == 0) PG8_BAR; }
        if constexpr (!Epi::AFTER_DRAIN) { E(acc, cur, wr, wc, fr, fq); S.done(cur); }
        if (!has_next) break;
#pragma unroll
        for (int a = 0; a < 2; ++a)
#pragma unroll
            for (int b = 0; b < 2; ++b)
#pragma unroll
                for (int m = 0; m < 4; ++m)
#pragma unroll
                    for (int n = 0; n < 2; ++n) acc[a][b][m][n] = (f32x4){0.f, 0.f, 0.f, 0.f};
        cur = nxt; cA = nA; cB = nB; ++ui;
        if constexpr (ALIGN_EPI) { if (wr == 1) PG8_BAR; }
    }
    PG8_WAIT_V(0);
    if constexpr (!ALIGN_EPI) { if (wr == 0) PG8_BAR; }
    PG8_BAR;
    if constexpr (Epi::AFTER_DRAIN) { E.fused(acc, cur, wr, wc, fr, fq, lds, wid, lane); S.done(cur); }
#undef PG8_SA
#undef PG8_SB
#undef PG8_STAGE
#undef PG8_LDA
#undef PG8_LDB
#undef PG8_MMA
#undef PG8_WAIT_V
#undef PG8_WAIT_L
#undef PG8_BAR
#undef PG8_SCHED
}
}

#ifndef MK_N_LAUNCHES
#define MK_N_LAUNCHES 1
#endif
#ifndef MK_PHMASK
#define MK_PHMASK 0x3ff
#endif
#define PHEN(t) (((MK_PHMASK) >> (t)) & 1)
#ifndef MK_DUP
#define MK_DUP 0
#endif
#ifndef MK_MIXDUP
#define MK_MIXDUP 0
#endif
#define REP(t, l) _Pragma("unroll 1") for (int rep_ = 0, nrep_ = ((l) == 0 ? KARG_I(200 + 4 * (t)) : 1); rep_ < nrep_; ++rep_)
constexpr int DM = 2048, MP = 16384, MS = 512, MT = MP + MS, SEQ = 2048, NIN = 3328, DFF = 5504, NUP = 11008;
constexpr int DEPTH = 2, NPH = 16;
constexpr float EPS = 1e-6f, LOG2E = 1.4426950408889634f;
constexpr size_t MiB = 1u << 20;
constexpr size_t SZ_WIN = (size_t)NIN * DM * 2, SZ_WO = (size_t)DM * DM * 2, SZ_WUP = (size_t)NUP * DM * 2, SZ_WDN = (size_t)DM * DFF * 2;
constexpr size_t WS_WIN = 1 * MiB, WS_WO = WS_WIN + 2 * 13 * MiB, WS_WUP = WS_WO + 2 * 8 * MiB, WS_WDN = WS_WUP + 2 * 43 * MiB;
constexpr size_t WS_XN = WS_WDN + 2 * 22 * MiB;
constexpr size_t WS_ACT = WS_XN + 66 * MiB;
constexpr size_t WS_Q = WS_ACT, WS_U = WS_Q + 33 * MiB, WS_VS = WS_U + 33 * MiB, WS_K = WS_VS + 33 * MiB, WS_V = WS_K + 5 * MiB, WS_MG = WS_V + 5 * MiB;
constexpr size_t WS_BND = WS_ACT + 178 * MiB;
constexpr size_t WS_HS = WS_BND + 43 * MiB;
constexpr size_t WS_PART = WS_HS + 22 * MiB;
constexpr size_t WS_END = WS_PART + 32 * MiB;
constexpr size_t WS_RSS = 256 * 1024;
constexpr int NSPLIT = 8;
static_assert(WS_MG + 66 * MiB <= WS_BND && SZ_WIN <= 13 * MiB && SZ_WO <= 8 * MiB && SZ_WUP <= 43 * MiB && SZ_WDN <= 22 * MiB, "ws map");
constexpr size_t O_YS = (size_t)MP * DM, O_KP = O_YS + (size_t)MS * DM, O_VP = O_KP + 262144, O_CP = O_VP + 262144, O_KS = O_CP + 352256, O_VSO = O_KS + 4194304,
                 O_CS = O_VSO + 4194304, O_SV = O_CS + 5636096, O_END = O_SV + 1048576;
constexpr int LDS_BYTES = 147456;
constexpr int CW_BAR = 4096;
constexpr int KS_OFF = 0, KS_STRIDE = 144, VT_OFF = 55296, VT_STRIDE = 400, ST_OFF = 110592;
constexpr int SG_WAVE = 32 * 272;

#define GAS __attribute__((address_space(1)))
#define LAS __attribute__((address_space(3)))
#define RLX_AGENT __ATOMIC_RELAXED, __HIP_MEMORY_SCOPE_AGENT
#define DI __device__ __forceinline__
typedef unsigned short bf16;
typedef unsigned v4u __attribute__((ext_vector_type(4)));
typedef unsigned v2u __attribute__((ext_vector_type(2)));
typedef float f32x4 __attribute__((ext_vector_type(4)));
typedef float f32x16 __attribute__((ext_vector_type(16)));
typedef short bf16x8 __attribute__((ext_vector_type(8)));
typedef short s16x4 __attribute__((ext_vector_type(4)));
#define MFMA32(a, b, c) __builtin_amdgcn_mfma_f32_32x32x16_bf16((a), (b), (c), 0, 0, 0)
#define LDS_WAIT() asm volatile("s_waitcnt lgkmcnt(0)" ::: "memory")

DI unsigned pk2(float lo, float hi) { unsigned r; asm volatile("v_cvt_pk_bf16_f32 %0, %1, %2" : "=v"(r) : "v"(lo), "v"(hi)); return r; }
DI float bflo(unsigned w) { return __uint_as_float(w << 16); }
DI float bfhi(unsigned w) { return __uint_as_float(w & 0xffff0000u); }
DI float fexp2(float x) { return __builtin_amdgcn_exp2f(x); }
DI float frcp(float x) { return __builtin_amdgcn_rcpf(x); }
DI float frsq(float x) { return __builtin_amdgcn_rsqf(x); }
DI float gelu_t(float x) { const float t = x * (1.0f + 0.044715f * x * x); return x * frcp(1.0f + fexp2(-2.302208198f * t)); }
DI float silu(float x) { return x * frcp(1.0f + fexp2(-LOG2E * x)); }
DI float wave_sum(float v) {
#pragma unroll
    for (int o = 1; o < 64; o <<= 1) v += __shfl_xor(v, o);
    return v;
}
DI int crow(int reg, int h) { return (reg & 3) + 8 * (reg >> 2) + 4 * h; }
DI float dpp_ror1(float s) { return __builtin_bit_cast(float, __builtin_amdgcn_update_dpp(0, __builtin_bit_cast(int, s), 0x121, 0xf, 0xf, false)); }
DI float dpp_ror2(float s) { return __builtin_bit_cast(float, __builtin_amdgcn_update_dpp(0, __builtin_bit_cast(int, s), 0x122, 0xf, 0xf, false)); }
DI float dpp_shr1(float o, float s) { return __builtin_bit_cast(float, __builtin_amdgcn_update_dpp(__builtin_bit_cast(int, o), __builtin_bit_cast(int, s), 0x111, 0xf, 0xf, false)); }
DI float dpp_shr2(float o, float s) { return __builtin_bit_cast(float, __builtin_amdgcn_update_dpp(__builtin_bit_cast(int, o), __builtin_bit_cast(int, s), 0x112, 0xf, 0xf, false)); }

struct Args { const float* in[22]; float* out; unsigned char* ws; int ph_lo, ph_hi; int rep[8]; };
struct Frame {
    LAS unsigned char* lds; int tid, lane, wave, G, bid;
    float* out; unsigned char* ws;
};
DI const float* INP(int k) { const char __attribute__((address_space(4)))* p = (const char __attribute__((address_space(4)))*)__builtin_amdgcn_kernarg_segment_ptr(); asm volatile("" : "+s"(p)); return (const float*)(((const GAS float* const __attribute__((address_space(4)))*)p)[k]); }
DI Frame opaque(const Frame& F0) { Frame F = F0; int ln = (int)__builtin_amdgcn_mbcnt_hi(~0u, __builtin_amdgcn_mbcnt_lo(~0u, 0u)); asm volatile("" : "+v"(ln)); F.lane = ln; F.tid = F0.wave * 64 + ln; return F; }
DI int KARG_I(int byteoff) { const char __attribute__((address_space(4)))* p = (const char __attribute__((address_space(4)))*)__builtin_amdgcn_kernarg_segment_ptr(); asm volatile("" : "+s"(p)); return *(const int __attribute__((address_space(4)))*)(p + byteoff); }
DI unsigned char* WSB(const Frame& F) { GAS unsigned char* p = (GAS unsigned char*)F.ws; asm volatile("" : "+s"(p)); return (unsigned char*)p; }
DI float* OUTB(const Frame& F) { GAS float* p = (GAS float*)F.out; asm volatile("" : "+s"(p)); return (float*)p; }

struct EpiIn {
    static constexpr bool PERM = false, AFTER_DRAIN = false;
    unsigned char* ws; float* out; int l;
    DI void operator()(const f32x4 (&acc)[2][2][4][2], const pg8::Unit& u, int wr, int wc, int fr, int fq) const {
        bf16 *Q = (bf16*)(ws + WS_Q), *Kb = (bf16*)(ws + WS_K), *Vb = (bf16*)(ws + WS_V), *U = (bf16*)(ws + WS_U), *VS = (bf16*)(ws + WS_VS);
        const float *gq = INP(7) + l * 64, *gk = INP(8) + l * 64; const float* rss = (const float*)(ws + WS_RSS) + MT;
        float *kwp = out + O_KP + (size_t)l * 131072, *vwp = out + O_VP + (size_t)l * 131072, *kws = out + O_KS + (size_t)l * 2097152, *vws = out + O_VSO + (size_t)l * 2097152;
        const int pn = u.pn;
        const bool isq = pn < 4, iskv = pn == 4, isk = iskv && wc < 2;
        f32x4 g[2][2];
        const float* gp = isq ? gq : gk;
#pragma unroll
        for (int bj = 0; bj < 2; ++bj)
#pragma unroll
            for (int n = 0; n < 2; ++n) g[bj][n] = (isq || isk) ? *(const f32x4*)(gp + 32 * bj + 8 * fq + 4 * n) : (f32x4){1.f, 1.f, 1.f, 1.f};
        f32x4 rsq4[2];
#pragma unroll
        for (int ai = 0; ai < 2; ++ai) rsq4[ai] = *(const f32x4*)(rss + u.pm * 256 + ai * 128 + wr * 64 + fr * 4);
        bf16* obase; int ld;
        if (isq) { obase = Q + pn * 256 + wc * 64; ld = 1024; }
        else if (iskv) { obase = (wc < 2 ? Kb : Vb) + (wc & 1) * 64; ld = 128; }
        else if (pn < 9) { obase = U + (pn - 5) * 256 + wc * 64; ld = 1024; }
        else { obase = VS + (pn - 9) * 256 + wc * 64; ld = 1024; }
#pragma unroll
        for (int ai = 0; ai < 2; ++ai)
#pragma unroll
            for (int m = 0; m < 4; ++m) {
                const int row = u.pm * 256 + ai * 128 + wr * 64 + fr * 4 + m;
                const float rsx = frsq(rsq4[ai][m] * (1.0f / DM) + EPS);
                f32x4 v[2][2];
#pragma unroll
                for (int bj = 0; bj < 2; ++bj)
#pragma unroll
                    for (int n = 0; n < 2; ++n) v[bj][n] = acc[ai][bj][m][n] * rsx;
                if (isq || isk) {
                    float ss = 0.f;
#pragma unroll
                    for (int bj = 0; bj < 2; ++bj)
#pragma unroll
                        for (int n = 0; n < 2; ++n) { const f32x4 x = v[bj][n]; ss += (x[0] * x[0] + x[1] * x[1]) + (x[2] * x[2] + x[3] * x[3]); }
                    ss += __shfl_xor(ss, 16); ss += __shfl_xor(ss, 32);
                    const float rs = frsq(ss * (1.0f / 64.0f) + EPS);
#pragma unroll
                    for (int bj = 0; bj < 2; ++bj)
#pragma unroll
                        for (int n = 0; n < 2; ++n) v[bj][n] = v[bj][n] * rs * g[bj][n];
                } else if (!iskv) {
#pragma unroll
                    for (int bj = 0; bj < 2; ++bj)
#pragma unroll
                        for (int n = 0; n < 2; ++n)
#pragma unroll
                            for (int e = 0; e < 4; ++e) v[bj][n][e] = gelu_t(v[bj][n][e]);
                }
                bf16* rowp = obase + (size_t)row * ld + 8 * fq;
#pragma unroll
                for (int bj = 0; bj < 2; ++bj) { v4u w; w.x = pk2(v[bj][0][0], v[bj][0][1]); w.y = pk2(v[bj][0][2], v[bj][0][3]); w.z = pk2(v[bj][1][0], v[bj][1][1]); w.w = pk2(v[bj][1][2], v[bj][1][3]);
                    *(v4u*)(rowp + 32 * bj) = w; }
                if (iskv) {
                    float* wb = nullptr;
                    if (row < MP) { const int t = row & (SEQ - 1); if (t >= SEQ - 128) wb = (wc < 2 ? kwp : vwp) + ((size_t)((row >> 11) * 128 + (t - (SEQ - 128))) * 2 + (wc & 1)) * 64; }
                    else { const int sr = row - MP; wb = (wc < 2 ? kws : vws) + ((size_t)((sr >> 2) * 128 + 124 + (sr & 3)) * 2 + (wc & 1)) * 64; }
                    if (wb) {
#pragma unroll
                        for (int bj = 0; bj < 2; ++bj)
#pragma unroll
                            for (int n = 0; n < 2; ++n) *(f32x4*)(wb + 32 * bj + 8 * fq + 4 * n) = v[bj][n];
                    }
                }
            }
    }
};
struct EpiRes {
    static constexpr bool PERM = false, AFTER_DRAIN = false;
    float* out; unsigned char* ws; int rsel; bool fin;
    DI void operator()(const f32x4 (&acc)[2][2][4][2], const pg8::Unit& u, int wr, int wc, int fr, int fq) const {
        const int col0 = u.pn * 256 + wc * 32 + 8 * fq;
        if (u.pm >= MP / 256) {
            float* P = (float*)(ws + WS_PART) + (size_t)u.sp * MS * DM;
#pragma unroll
            for (int ai = 0; ai < 2; ++ai)
#pragma unroll
                for (int m = 0; m < 4; ++m) { const size_t off = (size_t)((u.pm - MP / 256) * 256 + ai * 128 + wr * 64 + fr * 4 + m) * DM + col0;
#pragma unroll
                    for (int bj = 0; bj < 2; ++bj)
#pragma unroll
                        for (int n = 0; n < 2; ++n) *(f32x4*)(P + off + bj * 128 + n * 4) = acc[ai][bj][m][n]; }
            return;
        }
        bf16* XN = (bf16*)(ws + WS_XN); float* rss = (float*)(ws + WS_RSS) + rsel * MT;
#pragma unroll
        for (int ai = 0; ai < 2; ++ai) {
            v4u rw[1][4][2];
#pragma unroll
            for (int m = 0; m < 4; ++m)
#pragma unroll
                for (int bj = 0; bj < 2; ++bj) rw[0][m][bj] = *(const v4u*)(XN + (size_t)(u.pm * 256 + ai * 128 + wr * 64 + fr * 4 + m) * DM + col0 + bj * 128);
            asm volatile("" ::: "memory");
#pragma unroll
            for (int m = 0; m < 4; ++m) { const int row = u.pm * 256 + ai * 128 + wr * 64 + fr * 4 + m; const size_t off = (size_t)row * DM + col0; float ss = 0.f;
#pragma unroll
                for (int bj = 0; bj < 2; ++bj) { const v4u r4 = rw[0][m][bj];
                    const f32x4 x0 = (f32x4){bflo(r4.x), bfhi(r4.x), bflo(r4.y), bfhi(r4.y)} + acc[ai][bj][m][0], x1 = (f32x4){bflo(r4.z), bfhi(r4.z), bflo(r4.w), bfhi(r4.w)} + acc[ai][bj][m][1];
                    if (fin) { *(f32x4*)(out + off + bj * 128) = x0; *(f32x4*)(out + off + bj * 128 + 4) = x1; }
                    else { ss += (x0[0] * x0[0] + x0[1] * x0[1]) + (x0[2] * x0[2] + x0[3] * x0[3]) + (x1[0] * x1[0] + x1[1] * x1[1]) + (x1[2] * x1[2] + x1[3] * x1[3]);
                        v4u w; w.x = pk2(x0[0], x0[1]); w.y = pk2(x0[2], x0[3]); w.z = pk2(x1[0], x1[1]); w.w = pk2(x1[2], x1[3]); *(v4u*)(XN + off + bj * 128) = w; } }
                if (!fin) { ss += __shfl_xor(ss, 16); ss += __shfl_xor(ss, 32); if (fq == 0) unsafeAtomicAdd(rss + row, ss); } }
        }
    }
};
DI float dpp_up1(float s) { return __builtin_bit_cast(float, __builtin_amdgcn_update_dpp(0, __builtin_bit_cast(int, s), 0x111, 0xf, 0xf, true)); }
struct EpiUp {
    static constexpr bool PERM = false, AFTER_DRAIN = false;
    unsigned char* ws; int l;
    DI void operator()(f32x4 (&acc)[2][2][4][2], const pg8::Unit& u, int wr, int wc, int fr, int fq) const {
        bf16* ACT = (bf16*)(ws + WS_ACT); float *BND = (float*)(ws + WS_BND), *HS = (float*)(ws + WS_HS);
        const float *cw = INP(19) + (size_t)l * 3 * NUP, *cb = INP(20) + (size_t)l * NUP; const float* rss = (const float*)(ws + WS_RSS);
        const int cbase = 128 * u.pn + 32 * wc + 8 * fq;
#pragma unroll
        for (int ai = 0; ai < 2; ++ai) { const f32x4 q = *(const f32x4*)(rss + u.pm * 256 + ai * 128 + wr * 64 + fr * 4);
#pragma unroll
            for (int m = 0; m < 4; ++m) { const float rs = frsq(q[m] * (1.0f / DM) + EPS);
#pragma unroll
                for (int bj = 0; bj < 2; ++bj)
#pragma unroll
                    for (int n = 0; n < 2; ++n) acc[ai][bj][m][n] *= rs; } }
        if (u.pm >= MP / 256) {
#pragma unroll
            for (int ai = 0; ai < 2; ++ai)
#pragma unroll
                for (int m = 0; m < 4; ++m) { float* hp = HS + (size_t)((u.pm - MP / 256) * 256 + ai * 128 + wr * 64 + fr * 4 + m) * NUP + cbase;
#pragma unroll
                    for (int bj = 0; bj < 2; ++bj)
#pragma unroll
                        for (int n = 0; n < 2; ++n) *(f32x4*)(hp + bj * DFF + 4 * n) = acc[ai][bj][m][n]; }
            return;
        }
        v2u keep[2][4];
#pragma unroll
        for (int n = 0; n < 2; ++n) {
            const int ca = cbase + 4 * n;
            const f32x4 w0a = *(const f32x4*)(cw + ca), w1a = *(const f32x4*)(cw + NUP + ca), w2a = *(const f32x4*)(cw + 2 * NUP + ca), ba = *(const f32x4*)(cb + ca);
            const f32x4 w0g = *(const f32x4*)(cw + DFF + ca), w1g = *(const f32x4*)(cw + NUP + DFF + ca), w2g = *(const f32x4*)(cw + 2 * NUP + DFF + ca), bg = *(const f32x4*)(cb + DFF + ca);
#pragma unroll
            for (int ai = 0; ai < 2; ++ai) {
                const int row0 = u.pm * 256 + ai * 128 + wr * 64 + fr * 4;
                const f32x4 a0 = acc[ai][0][0][n], a1 = acc[ai][0][1][n], a2 = acc[ai][0][2][n], a3 = acc[ai][0][3][n];
                const f32x4 g0 = acc[ai][1][0][n], g1 = acc[ai][1][1][n], g2 = acc[ai][1][2][n], g3 = acc[ai][1][3][n];
                f32x4 am1, am2, gm1, gm2;
#pragma unroll
                for (int e = 0; e < 4; ++e) { am1[e] = dpp_up1(a3[e]); am2[e] = dpp_up1(a2[e]); gm1[e] = dpp_up1(g3[e]); gm2[e] = dpp_up1(g2[e]); }
                f32x4 ha[4], hg[4];
                ha[0] = ba + w0a * am2 + w1a * am1 + w2a * a0; ha[1] = ba + w0a * am1 + w1a * a0 + w2a * a1; ha[2] = ba + w0a * a0 + w1a * a1 + w2a * a2; ha[3] = ba + w0a * a1 + w1a * a2 + w2a * a3;
                hg[0] = bg + w0g * gm2 + w1g * gm1 + w2g * g0; hg[1] = bg + w0g * gm1 + w1g * g0 + w2g * g1; hg[2] = bg + w0g * g0 + w1g * g1 + w2g * g2; hg[3] = bg + w0g * g1 + w1g * g2 + w2g * g3;
#pragma unroll
                for (int m = 0; m < 4; ++m) { v2u w; w.x = pk2(ha[m][0] * silu(hg[m][0]), ha[m][1] * silu(hg[m][1])); w.y = pk2(ha[m][2] * silu(hg[m][2]), ha[m][3] * silu(hg[m][3]));
                    if (n == 0) keep[ai][m] = w;
                    else { v4u w4; w4.x = keep[ai][m].x; w4.y = keep[ai][m].y; w4.z = w.x; w4.w = w.y; *(v4u*)(ACT + (size_t)(row0 + m) * DFF + cbase) = w4; } }
                float* bp = BND + (size_t)(row0 >> 6) * 4 * NUP + ca;
                if (fr == 0) { *(f32x4*)bp = a0; *(f32x4*)(bp + DFF) = g0; *(f32x4*)(bp + NUP) = a1; *(f32x4*)(bp + NUP + DFF) = g1; }
                if (fr == 15) { *(f32x4*)(bp + 2 * NUP) = a2; *(f32x4*)(bp + 2 * NUP + DFF) = g2; *(f32x4*)(bp + 3 * NUP) = a3; *(f32x4*)(bp + 3 * NUP + DFF) = g3; }
            }
        }
    }
};

template <int MAP> DI int slot_of(int c) {
    if (MAP == 1) { const int pn = c >> 8, t = c & 255, wc = t >> 6, i = t & 63, bj = i >> 5, r32 = i & 31, fq = r32 >> 3, n = (r32 >> 2) & 1, e = r32 & 3; return pn * 256 + bj * 128 + wc * 32 + n * 16 + fq * 4 + e; }
    if (MAP == 2) { const int part = c >= DFF ? 1 : 0, j = c - part * DFF, pn = j >> 7, i = j & 127, wc = i >> 5, r32 = i & 31, fq = r32 >> 3, n = (r32 >> 2) & 1, e = r32 & 3; return pn * 256 + part * 128 + wc * 32 + n * 16 + fq * 4 + e; }
    if (MAP == 3) { const int pn = c >> 8, t = c & 255, bj = t >> 7, wc = (t >> 5) & 3, r32 = t & 31, fq = r32 >> 3, n = (r32 >> 2) & 1, e = r32 & 3; return pn * 256 + bj * 128 + wc * 32 + n * 16 + fq * 4 + e; }
    return c;
}
template <int MAP> DI void transpose_item(const float* W, const float* gk  , int K, int N, bf16* WT, LAS unsigned* scr, int item, int lane) {
    const int nblk = N / 64, kb = item / nblk, nb = item % nblk, k0 = 64 * kb, n0 = 64 * nb;
    const int q = lane & 15, kp = lane >> 4;
#pragma unroll
    for (int i = 0; i < 8; ++i) { const int kpair = kp + 4 * i; const float* p = W + (size_t)(k0 + 2 * kpair) * N + n0 + 4 * q;
        const float g0 = gk ? gk[k0 + 2 * kpair] : 1.0f, g1 = gk ? gk[k0 + 2 * kpair + 1] : 1.0f;
        const f32x4 r0 = *(const f32x4*)p * g0, r1 = *(const f32x4*)(p + N) * g1;
#pragma unroll
        for (int j = 0; j < 4; ++j) scr[(4 * q + j) * 33 + kpair] = pk2(r0[j], r1[j]); }
    LDS_WAIT();
    const int c = lane & 7;
#pragma unroll
    for (int i = 0; i < 8; ++i) { const int n = (lane >> 3) + 8 * i; const LAS unsigned* s = scr + n * 33 + 4 * c; v4u o; o.x = s[0]; o.y = s[1]; o.z = s[2]; o.w = s[3];
        *(v4u*)(WT + (size_t)slot_of<MAP>(n0 + n) * K + k0 + 8 * c) = o; }
    LDS_WAIT();
}
DI void xg_row(const float* xrow, bf16* orow, float* rss, int lane) {
    f32x4 v[8]; float s = 0.f;
#pragma unroll
    for (int j = 0; j < 8; ++j) { v[j] = *((const f32x4*)xrow + lane + 64 * j); s += (v[j][0] * v[j][0] + v[j][1] * v[j][1]) + (v[j][2] * v[j][2] + v[j][3] * v[j][3]); }
    s = wave_sum(s); if (lane == 0) *rss = s;
#pragma unroll
    for (int j = 0; j < 8; ++j) { v2u w; w.x = pk2(v[j][0], v[j][1]); w.y = pk2(v[j][2], v[j][3]); *((v2u*)orow + lane + 64 * j) = w; }
}
DI void reduce_phase(Frame& F0, int rsel, bool fin) {
    Frame F = opaque(F0);
    unsigned char* ws = WSB(F); const float* P = (const float*)(ws + WS_PART); float* out = OUTB(F) + (size_t)MP * DM; bf16* XN = (bf16*)(ws + WS_XN) + (size_t)MP * DM; float* rss = (float*)(ws + WS_RSS) + rsel * MT + MP;
    for (int r = F.bid * 8 + F.wave; r < MS; r += F.G * 8) {
        f32x4 v[8]; float s = 0.f;
#pragma unroll
        for (int j = 0; j < 8; ++j) { const v2u w = *((const v2u*)(XN + (size_t)r * DM) + F.lane + 64 * j); v[j] = (f32x4){bflo(w.x), bfhi(w.x), bflo(w.y), bfhi(w.y)}; }
#pragma unroll 1
        for (int sp = 0; sp < NSPLIT; ++sp) {
#pragma unroll
            for (int j = 0; j < 8; ++j) v[j] += *((const f32x4*)(P + ((size_t)sp * MS + r) * DM) + F.lane + 64 * j); }
#pragma unroll
        for (int j = 0; j < 8; ++j) { s += (v[j][0] * v[j][0] + v[j][1] * v[j][1]) + (v[j][2] * v[j][2] + v[j][3] * v[j][3]);
            if (fin) *((f32x4*)(out + (size_t)r * DM) + F.lane + 64 * j) = v[j];
            else { v2u w; w.x = pk2(v[j][0], v[j][1]); w.y = pk2(v[j][2], v[j][3]); *((v2u*)(XN + (size_t)r * DM) + F.lane + 64 * j) = w; } }
        if (!fin) { s = wave_sum(s); if (F.lane == 0) rss[r] = s; }
    }
}
DI void zero_rss(Frame& F0, int rsel) {
    Frame F = opaque(F0); float* rss = (float*)(WSB(F) + WS_RSS) + rsel * MT;
    for (int i = F.bid * 512 + F.tid; i < MP; i += F.G * 512) rss[i] = 0.f;
}
DI void norm_phase(Frame& F0, const float* xp, const float* xs  ) {
    Frame F = opaque(F0);
    bf16* XN = (bf16*)(WSB(F) + WS_XN); float* rss = (float*)(WSB(F) + WS_RSS) + MT;
    for (int m = F.bid * 8 + F.wave; m < MT; m += F.G * 8) xg_row((m < MP ? xp : xs) + (size_t)m * DM, XN + (size_t)m * DM, rss + m, F.lane);
}
DI void convert_weights(Frame& F0, int l, int cu0, int i0, int i1) {
    Frame F = opaque(F0);
    if (F.bid < cu0) return;
    LAS unsigned* scr = (LAS unsigned*)(F.lds + F.wave * 16384);
    const int gw = (F.bid - cu0) * 8 + F.wave, NGW = (F.G - cu0) * 8;
    constexpr int I_IN = (DM / 64) * (NIN / 64), I_O = (DM / 64) * (DM / 64), I_UP = (DM / 64) * (NUP / 64), I_DN = (DFF / 64) * (DM / 64), I_L = I_IN + I_O + I_UP + I_DN;
    for (int it = i0 + gw; it < i1; it += NGW) {
        int r = it;
        if (r < I_IN) { transpose_item<1>(INP(6) + (size_t)l * DM * NIN, INP(5) + l * DM, DM, NIN, (bf16*)(WSB(F) + WS_WIN + l * 13 * MiB), scr, r, F.lane); continue; } r -= I_IN;
        if (r < I_O) { transpose_item<3>(INP(16) + (size_t)l * DM * DM, nullptr, DM, DM, (bf16*)(WSB(F) + WS_WO + l * 8 * MiB), scr, r, F.lane); continue; } r -= I_O;
        if (r < I_UP) { transpose_item<2>(INP(18) + (size_t)l * DM * NUP, INP(17) + l * DM, DM, NUP, (bf16*)(WSB(F) + WS_WUP + l * 43 * MiB), scr, r, F.lane); continue; } r -= I_UP;
        transpose_item<3>(INP(21) + (size_t)l * DFF * DM, nullptr, DFF, DM, (bf16*)(WSB(F) + WS_WDN + l * 22 * MiB), scr, r, F.lane);
    }
    __syncthreads();
}
constexpr int CV_IN = (DM / 64) * (NIN / 64), CV_O = CV_IN + (DM / 64) * (DM / 64), CV_UP = CV_O + (DM / 64) * (NUP / 64), CV_ALL = CV_UP + (DFF / 64) * (DM / 64);
DI void prologue(Frame& F0) {
    convert_weights(F0, 0, 0, 0, CV_O);
    norm_phase(F0, INP(0), INP(1) - (size_t)MP * DM);
}

DI void load_q(bf16x8 (&bq)[4], const bf16* qptr, int hh) {
#pragma unroll
    for (int ks = 0; ks < 4; ++ks) bq[ks] = *(const bf16x8*)(qptr + 16 * ks + 8 * hh);
}
DI float attn_qblock(LAS unsigned char* lds, int kv, int kb0, const bf16x8 (&bq)[4], int distbase, int kimin, float slope2, float sink2, bf16* optr, int lane) {
    const int r = lane & 31, hh = lane >> 5;
    f32x16 s[5];
#pragma unroll
    for (int t = 0; t < 5; ++t) {
#pragma unroll
        for (int i = 0; i < 16; ++i) s[t][i] = 0.f;
#pragma unroll
        for (int ks = 0; ks < 4; ++ks) { const bf16x8 kf = *(const LAS bf16x8*)(lds + KS_OFF + (kv * 192 + 32 * (kb0 + t) + r) * KS_STRIDE + (16 * ks + 8 * hh) * 2); s[t] = MFMA32(kf, bq[ks], s[t]); }
        if (t & 1) __builtin_amdgcn_sched_barrier(0);
    }
    __builtin_amdgcn_sched_barrier(0);
    float mx = sink2;
    int kloi = max(kimin, distbase - 127) - 32 * kb0 - 4 * hh, khii = distbase - 32 * kb0 - 4 * hh;
    asm volatile("" : "+v"(kloi), "+v"(khii));
    const float klof = (float)kloi, khif = (float)khii, base = -slope2 * khif;
#pragma unroll
    for (int t = 0; t < 5; ++t)
#pragma unroll
        for (int i = 0; i < 16; ++i) { const float kkf = (float)(32 * t + crow(i, 0));
            const float x = __builtin_fmaf(slope2, kkf, __builtin_fmaf(s[t][i], 0.125f * LOG2E, base));
            const int msk = __float_as_int(fminf(kkf - klof, khif - kkf)) >> 31;
            const float v = __int_as_float((__float_as_int(x) & ~msk) | (__float_as_int(-1e30f) & msk)); s[t][i] = v; mx = fmaxf(mx, v); }
    mx = fmaxf(mx, __shfl_xor(mx, 32));
    float l = 0.f;
#pragma unroll
    for (int t = 0; t < 5; ++t)
#pragma unroll
        for (int i = 0; i < 16; ++i) { const float p = fexp2(s[t][i] - mx); s[t][i] = p; l += p; }
    l += __shfl_xor(l, 32); l += fexp2(sink2 - mx);
    __builtin_amdgcn_sched_barrier(0);
    f32x16 o[2];
#pragma unroll
    for (int db = 0; db < 2; ++db)
#pragma unroll
        for (int i = 0; i < 16; ++i) o[db][i] = 0.f;
#pragma unroll
    for (int t = 0; t < 5; ++t)
#pragma unroll
        for (int st = 0; st < 2; ++st) {
            v4u pw; pw.x = pk2(s[t][8 * st], s[t][8 * st + 1]); pw.y = pk2(s[t][8 * st + 2], s[t][8 * st + 3]); pw.z = pk2(s[t][8 * st + 4], s[t][8 * st + 5]); pw.w = pk2(s[t][8 * st + 6], s[t][8 * st + 7]);
            const bf16x8 pf = __builtin_bit_cast(bf16x8, pw);
#pragma unroll
            for (int db = 0; db < 2; ++db) { const LAS unsigned char* a = lds + VT_OFF + (kv * 64 + 32 * db + r) * VT_STRIDE + (32 * (kb0 + t) + 16 * st + 4 * hh) * 2;
                const s16x4 lo = *(const LAS s16x4*)a, hi = *(const LAS s16x4*)(a + 16); const bf16x8 vf = __builtin_shufflevector(lo, hi, 0, 1, 2, 3, 4, 5, 6, 7);
                o[db] = MFMA32(vf, pf, o[db]); }
        }
    const float inv = frcp(l); float ssq = 0.f;
#pragma unroll
    for (int db = 0; db < 2; ++db)
#pragma unroll
        for (int g = 0; g < 4; ++g) { const float a0 = o[db][4 * g] * inv, a1 = o[db][4 * g + 1] * inv, a2 = o[db][4 * g + 2] * inv, a3 = o[db][4 * g + 3] * inv;
            ssq += (a0 * a0 + a1 * a1) + (a2 * a2 + a3 * a3); v2u w; w.x = pk2(a0, a1); w.y = pk2(a2, a3); *(v2u*)(optr + 32 * db + 8 * g + 4 * hh) = w; }
    return ssq;
}
DI void put_k(LAS unsigned char* lds, int kv, int ki, int d0, v4u w) { *(LAS v4u*)(lds + KS_OFF + (kv * 192 + ki) * KS_STRIDE + d0 * 2) = w; }
DI void put_v(LAS unsigned char* lds, int kv, int ki, int d0, v4u w) {
    LAS unsigned short* p = (LAS unsigned short*)(lds + VT_OFF + (kv * 64 + d0) * VT_STRIDE + ki * 2);
    p[0 * (VT_STRIDE / 2)] = (unsigned short)(w.x & 0xffff); p[1 * (VT_STRIDE / 2)] = (unsigned short)(w.x >> 16); p[2 * (VT_STRIDE / 2)] = (unsigned short)(w.y & 0xffff); p[3 * (VT_STRIDE / 2)] = (unsigned short)(w.y >> 16);
    p[4 * (VT_STRIDE / 2)] = (unsigned short)(w.z & 0xffff); p[5 * (VT_STRIDE / 2)] = (unsigned short)(w.z >> 16); p[6 * (VT_STRIDE / 2)] = (unsigned short)(w.w & 0xffff); p[7 * (VT_STRIDE / 2)] = (unsigned short)(w.w >> 16);
}
DI void rescale_rows(Frame& F, bf16* MG, int m0, int nrows, const float* goa, const float* gos) {
    LAS float* ST = (LAS float*)(F.lds + ST_OFF);
#pragma unroll 4
    for (int c = F.tid; c < nrows * 256; c += 512) { const int row = c >> 8, cc = (c & 255) * 8; bf16* p = MG + (size_t)(m0 + row) * DM + cc; const v4u raw = *(const v4u*)p;
        const float sc = cc < 1024 ? ST[1280 + row] : ST[1344 + row]; const float* gp = cc < 1024 ? goa + cc : gos + (cc - 1024); const f32x4 g0 = *(const f32x4*)gp, g1 = *(const f32x4*)(gp + 4);
        v4u w; w.x = pk2(bflo(raw.x) * sc * g0[0], bfhi(raw.x) * sc * g0[1]); w.y = pk2(bflo(raw.y) * sc * g0[2], bfhi(raw.y) * sc * g0[3]);
        w.z = pk2(bflo(raw.z) * sc * g1[0], bfhi(raw.z) * sc * g1[1]); w.w = pk2(bflo(raw.w) * sc * g1[2], bfhi(raw.w) * sc * g1[3]); *(v4u*)p = w; }
}
DI void mixer_prompt_item(Frame& F0, int l, int item) {
    Frame F = opaque(F0);
    const bf16 *Q = (const bf16*)(WSB(F) + WS_Q), *Kb = (const bf16*)(WSB(F) + WS_K), *Vb = (const bf16*)(WSB(F) + WS_V), *U = (const bf16*)(WSB(F) + WS_U), *VS = (const bf16*)(WSB(F) + WS_VS);
    bf16* MG = (bf16*)(WSB(F) + WS_MG);
    LAS float* ST = (LAS float*)(F.lds + ST_OFF);
    const int b = item >> 5, t0 = (item & 31) * 64, m0 = b * SEQ + t0, tq = t0 & 64, mc = m0 - tq, S = tq + 64;
    const int lane = F.lane, w = F.wave, r = lane & 31, hh = lane >> 5;
    for (int c = F.tid; c < 192 * 16; c += 512) { const int ki = c >> 4, ch = c & 15, kv = ch >> 3, d0 = (ch & 7) * 8; int pos = t0 - 128 + ki; pos = pos < 0 ? 0 : pos;
        const size_t off = (size_t)(b * SEQ + pos) * 128 + kv * 64 + d0; put_k(F.lds, kv, ki, d0, *(const v4u*)(Kb + off)); put_v(F.lds, kv, ki, d0, *(const v4u*)(Vb + off)); }
    __syncthreads();
    for (int rp_ = 0; rp_ < ((MK_MIXDUP & 1) ? 2 : 1); ++rp_)
    {
        const int kv = w >> 2; float sq0 = 0.f, sq1 = 0.f;
        bf16x8 bq[4], bqn[4];
        load_q(bq, Q + (size_t)(m0 + r) * 1024 + (2 * w) * 64, hh);
        const float* sinks = INP(9) + l * 16;
#pragma unroll 1
        for (int it = 0; it < 4; ++it) { const int hs = it >> 1, qb = it & 1; const int h = 2 * w + hs; const float slope2 = fexp2(-0.5f * (float)(h + 1)) * LOG2E, sink2 = sinks[h] * LOG2E;
            const int row = m0 + 32 * qb + r;
            load_q(bq, Q + (size_t)row * 1024 + h * 64, hh);
            float s = attn_qblock(F.lds, kv, qb, bq, 32 * qb + r + 128, 128 - t0, slope2, sink2, MG + (size_t)row * DM + h * 64, lane);
            s += __shfl_xor(s, 32); sq0 += qb == 0 ? s : 0.f; sq1 += qb == 1 ? s : 0.f;
}
        if (hh == 0) { ST[w * 64 + r] = sq0; ST[w * 64 + 32 + r] = sq1; }
    }
    __syncthreads();
#pragma unroll 1
    for (int rq_ = 0; rq_ < ((MK_MIXDUP & 2) ? 2 : 1); ++rq_) {
    for (int sb = w; sb < S; sb += 32) {
        v4u a[4], c[4];
#pragma unroll
        for (int k = 0; k < 4; ++k) { const bf16* p = VS + (size_t)(mc + sb + 8 * k) * 1024 + 8 * lane; a[k] = *(const v4u*)p; c[k] = *(const v4u*)(p + 512); }
#pragma unroll
        for (int k = 0; k < 4; ++k) {
            const float x[16] = {bflo(a[k].x), bfhi(a[k].x), bflo(a[k].y), bfhi(a[k].y), bflo(a[k].z), bfhi(a[k].z), bflo(a[k].w), bfhi(a[k].w), bflo(c[k].x), bfhi(c[k].x), bflo(c[k].y), bfhi(c[k].y), bflo(c[k].z), bfhi(c[k].z), bflo(c[k].w), bfhi(c[k].w)};
            float sm = 0.f, s2 = 0.f;
#pragma unroll
            for (int j = 0; j < 16; ++j) { sm += x[j]; s2 += x[j] * x[j]; }
            sm = wave_sum(sm); s2 = wave_sum(s2); const float mu = sm * (1.0f / 1024.0f), var = s2 * (1.0f / 1024.0f) - mu * mu;
            if (lane == 0) { ST[1024 + sb + 8 * k] = mu; ST[1152 + sb + 8 * k] = frsq(fmaxf(var, 0.f) + EPS); } } }
    __syncthreads();
    {
        const int h = w; LAS unsigned char* vst = F.lds + w * SG_WAVE;
        const float* lng = INP(10) + l * 1024 + h * 128; const float* lnb = INP(11) + l * 1024 + h * 128;
        const float* Wl = INP(12) + (size_t)(l * 8 + h) * 128 * 128; const float* bsl = INP(13) + (l * 8 + h) * 128;
        float sq0 = 0.f, sq1 = 0.f;
        bf16x8 wf[2][8];
#pragma unroll
        for (int tb = 0; tb < 2; ++tb) { const int t = tq + 32 * tb + r, nks = (tq + 32 * tb + 32) >> 4;
#pragma unroll
            for (int ks = 0; ks < 8; ++ks) { v4u bw = (v4u){0u, 0u, 0u, 0u};
                if (ks < nks) { const int s0 = 16 * ks + 8 * hh; const float* wp = Wl + (size_t)t * 128 + s0; const f32x4 w0 = *(const f32x4*)wp, w1 = *(const f32x4*)(wp + 4);
                    bw.x = pk2(s0 <= t ? w0[0] : 0.f, s0 + 1 <= t ? w0[1] : 0.f); bw.y = pk2(s0 + 2 <= t ? w0[2] : 0.f, s0 + 3 <= t ? w0[3] : 0.f);
                    bw.z = pk2(s0 + 4 <= t ? w1[0] : 0.f, s0 + 5 <= t ? w1[1] : 0.f); bw.w = pk2(s0 + 6 <= t ? w1[2] : 0.f, s0 + 7 <= t ? w1[3] : 0.f); }
                wf[tb][ks] = __builtin_bit_cast(bf16x8, bw); } }
        const int nch = S * 4;
#pragma unroll 1
        for (int eq = 0; eq < 4; ++eq) {
            { const int e0 = (lane & 3) * 8; const f32x4 g0 = *(const f32x4*)(lng + 32 * eq + e0), g1 = *(const f32x4*)(lng + 32 * eq + e0 + 4), b0 = *(const f32x4*)(lnb + 32 * eq + e0), b1 = *(const f32x4*)(lnb + 32 * eq + e0 + 4);
#pragma unroll 1
            for (int ib = 0; ib < nch; ib += 256) {
                v4u raw[4];
#pragma unroll
                for (int i = 0; i < 4; ++i) { const int c = ib + lane + 64 * i; raw[i] = *(const v4u*)(VS + (size_t)(mc + (c >> 2)) * 1024 + h * 128 + 32 * eq + (c & 3) * 8); }
#pragma unroll
                for (int i = 0; i < 4; ++i) { const int c = ib + lane + 64 * i; const int s = c >> 2; const float mu = ST[1024 + s], rs = ST[1152 + s]; const v4u rw = raw[i];
                    const unsigned y01 = pk2((bflo(rw.x) - mu) * rs * g0[0] + b0[0], (bfhi(rw.x) - mu) * rs * g0[1] + b0[1]), y23 = pk2((bflo(rw.y) - mu) * rs * g0[2] + b0[2], (bfhi(rw.y) - mu) * rs * g0[3] + b0[3]);
                    const unsigned y45 = pk2((bflo(rw.z) - mu) * rs * g1[0] + b1[0], (bfhi(rw.z) - mu) * rs * g1[1] + b1[1]), y67 = pk2((bflo(rw.w) - mu) * rs * g1[2] + b1[2], (bfhi(rw.w) - mu) * rs * g1[3] + b1[3]);
                    LAS unsigned short* p = (LAS unsigned short*)(vst + e0 * 272 + s * 2);
                    p[0] = (unsigned short)(y01 & 0xffff); p[136] = (unsigned short)(y01 >> 16); p[272] = (unsigned short)(y23 & 0xffff); p[408] = (unsigned short)(y23 >> 16);
                    p[544] = (unsigned short)(y45 & 0xffff); p[680] = (unsigned short)(y45 >> 16); p[816] = (unsigned short)(y67 & 0xffff); p[952] = (unsigned short)(y67 >> 16); } } }
            LDS_WAIT();
#pragma unroll
            for (int tb = 0; tb < 2; ++tb) {
                const int t = tq + 32 * tb + r, nks = (tq + 32 * tb + 32) >> 4;
                const float bs = bsl[t]; const size_t row = (size_t)(mc + t);
                v2u ur[4];
#pragma unroll
                for (int g = 0; g < 4; ++g) ur[g] = *(const v2u*)(U + row * 1024 + h * 128 + 32 * eq + 8 * g + 4 * hh);
                f32x16 acc;
#pragma unroll
                for (int i = 0; i < 16; ++i) acc[i] = 0.f;
#pragma unroll
                for (int ks = 0; ks < 8; ++ks) if (ks < nks) { const bf16x8 af = *(const LAS bf16x8*)(vst + r * 272 + (16 * ks + 8 * hh) * 2); acc = MFMA32(af, wf[tb][ks], acc); }
                float ss = 0.f;
#pragma unroll
                for (int g = 0; g < 4; ++g) { const int e = 32 * eq + 8 * g + 4 * hh;
                    const float a0 = (acc[4 * g] + bs) * bflo(ur[g].x), a1 = (acc[4 * g + 1] + bs) * bfhi(ur[g].x), a2 = (acc[4 * g + 2] + bs) * bflo(ur[g].y), a3 = (acc[4 * g + 3] + bs) * bfhi(ur[g].y);
                    ss += (a0 * a0 + a1 * a1) + (a2 * a2 + a3 * a3); v2u o; o.x = pk2(a0, a1); o.y = pk2(a2, a3); *(v2u*)(MG + row * DM + 1024 + h * 128 + e) = o; }
                ss += __shfl_xor(ss, 32); if (tb == 0) sq0 += ss; else sq1 += ss;
            }
            LDS_WAIT();
        }
        if (hh == 0) { ST[512 + w * 64 + r] = sq0; ST[512 + w * 64 + 32 + r] = sq1; }
    }
    __syncthreads();
    }
    if (F.tid < 64) { float a = 0.f, s = 0.f;
#pragma unroll
        for (int k = 0; k < 8; ++k) { a += ST[k * 64 + F.tid]; s += ST[512 + k * 64 + F.tid]; }
        ST[1280 + F.tid] = frsq(a * (1.0f / 1024.0f) + EPS); ST[1344 + F.tid] = frsq(s * (1.0f / 1024.0f) + EPS); }
    __syncthreads();
    rescale_rows(F, MG, m0, 64, INP(14) + l * 1024, INP(15) + l * 1024);
    __syncthreads();
}
DI void mixer_sample_item(Frame& F0, int l, int seq) {
    Frame F = opaque(F0);
    const bf16 *Q = (const bf16*)(WSB(F) + WS_Q), *Kb = (const bf16*)(WSB(F) + WS_K), *Vb = (const bf16*)(WSB(F) + WS_V), *U = (const bf16*)(WSB(F) + WS_U), *VS = (const bf16*)(WSB(F) + WS_VS);
    bf16* MG = (bf16*)(WSB(F) + WS_MG);
    LAS float* ST = (LAS float*)(F.lds + ST_OFF);
    const int lane = F.lane, w = F.wave, m0 = MP + seq * 4;
    const float* ck = INP(2) + (size_t)(l * 128 + seq) * 128 * 128; const float* cv = INP(3) + (size_t)(l * 128 + seq) * 128 * 128;
    float* okw = OUTB(F) + O_KS + (size_t)(l * 128 + seq) * 128 * 128; float* ovw = OUTB(F) + O_VSO + (size_t)(l * 128 + seq) * 128 * 128;
    if (F.tid < 8) ST[F.tid] = 0.f;
    for (int c = F.tid; c < 160 * 16; c += 512) { const int ki = c >> 4, ch = c & 15, kv = ch >> 3, d0 = (ch & 7) * 8; v4u kw, vw;
        if (ki < 128) { const float* kp = ck + (size_t)ki * 128 + kv * 64 + d0; const float* vp = cv + (size_t)ki * 128 + kv * 64 + d0;
            const f32x4 k0 = *(const f32x4*)kp, k1 = *(const f32x4*)(kp + 4), v0 = *(const f32x4*)vp, v1 = *(const f32x4*)(vp + 4);
            if (ki >= 4) { float* ok = okw + (size_t)(ki - 4) * 128 + kv * 64 + d0; float* ov = ovw + (size_t)(ki - 4) * 128 + kv * 64 + d0; *(f32x4*)ok = k0; *(f32x4*)(ok + 4) = k1; *(f32x4*)ov = v0; *(f32x4*)(ov + 4) = v1; }
            kw.x = pk2(k0[0], k0[1]); kw.y = pk2(k0[2], k0[3]); kw.z = pk2(k1[0], k1[1]); kw.w = pk2(k1[2], k1[3]); vw.x = pk2(v0[0], v0[1]); vw.y = pk2(v0[2], v0[3]); vw.z = pk2(v1[0], v1[1]); vw.w = pk2(v1[2], v1[3]);
        } else if (ki < 132) { const size_t off = (size_t)(m0 + ki - 128) * 128 + kv * 64 + d0; kw = *(const v4u*)(Kb + off); vw = *(const v4u*)(Vb + off); }
        else { kw = (v4u){0u, 0u, 0u, 0u}; vw = kw; }
        put_k(F.lds, kv, ki, d0, kw); put_v(F.lds, kv, ki, d0, vw); }
    __syncthreads();
    if (w < 2) { const int kv = w, j = lane & 31, t = j >> 3, h = kv * 8 + (j & 7), row = m0 + t; const float slope2 = fexp2(-0.5f * (float)(h + 1)) * LOG2E, sink2 = INP(9)[l * 16 + h] * LOG2E;
        bf16x8 bq[4]; load_q(bq, Q + (size_t)row * 1024 + h * 64, lane >> 5);
        float s = attn_qblock(F.lds, kv, 0, bq, 128 + t, 0, slope2, sink2, MG + (size_t)row * DM + h * 64, lane);
        atomicAdd((float*)(ST + t), s); }
    __syncthreads();
    LAS float* VN = (LAS float*)F.lds;
    if (w < 4) { const bf16* p = VS + (size_t)(m0 + w) * 1024 + 8 * lane; const v4u a = *(const v4u*)p, c = *(const v4u*)(p + 512);
        float x[16] = {bflo(a.x), bfhi(a.x), bflo(a.y), bfhi(a.y), bflo(a.z), bfhi(a.z), bflo(a.w), bfhi(a.w), bflo(c.x), bfhi(c.x), bflo(c.y), bfhi(c.y), bflo(c.z), bfhi(c.z), bflo(c.w), bfhi(c.w)};
        float sm = 0.f, s2 = 0.f;
#pragma unroll
        for (int j = 0; j < 16; ++j) { sm += x[j]; s2 += x[j] * x[j]; }
        sm = wave_sum(sm); s2 = wave_sum(s2); const float mu = sm * (1.0f / 1024.0f), rs = frsq(fmaxf(s2 * (1.0f / 1024.0f) - mu * mu, 0.f) + EPS);
        const float* lng = INP(10) + l * 1024; const float* lnb = INP(11) + l * 1024; float* osv = OUTB(F) + O_SV + (size_t)((l * 128 + seq) * 4 + w) * 1024;
#pragma unroll
        for (int hf = 0; hf < 2; ++hf) { const int c0 = 512 * hf + 8 * lane;
#pragma unroll
            for (int q4 = 0; q4 < 2; ++q4) { const f32x4 g = *(const f32x4*)(lng + c0 + 4 * q4), bb = *(const f32x4*)(lnb + c0 + 4 * q4); f32x4 y;
#pragma unroll
                for (int e = 0; e < 4; ++e) y[e] = (x[8 * hf + 4 * q4 + e] - mu) * rs * g[e] + bb[e];
                *(f32x4*)(osv + c0 + 4 * q4) = y; *(LAS f32x4*)(VN + w * 1024 + c0 + 4 * q4) = y; } } }
    __syncthreads();
    { const int t = F.tid >> 7, c0 = (F.tid & 127) * 8, h = c0 >> 7; const float* Wr = INP(12) + ((size_t)(l * 8 + h) * 128 + t) * 128; const float bs = INP(13)[(l * 8 + h) * 128 + t];
        const v4u ur = *(const v4u*)(U + (size_t)(m0 + t) * 1024 + c0); const float uu[8] = {bflo(ur.x), bfhi(ur.x), bflo(ur.y), bfhi(ur.y), bflo(ur.z), bfhi(ur.z), bflo(ur.w), bfhi(ur.w)};
        float o[8]; float ss = 0.f;
#pragma unroll
        for (int j = 0; j < 8; ++j) { float mix = bs;
#pragma unroll
            for (int s = 0; s < 4; ++s) mix += (s <= t ? Wr[s] : 0.f) * VN[s * 1024 + c0 + j];
            o[j] = uu[j] * mix; ss += o[j] * o[j]; }
        v4u wv; wv.x = pk2(o[0], o[1]); wv.y = pk2(o[2], o[3]); wv.z = pk2(o[4], o[5]); wv.w = pk2(o[6], o[7]); *(v4u*)(MG + (size_t)(m0 + t) * DM + 1024 + c0) = wv;
        ss = wave_sum(ss); if (lane == 0) atomicAdd((float*)(ST + 4 + t), ss); }
    __syncthreads();
    if (F.tid < 4) { ST[1280 + F.tid] = frsq(ST[F.tid] * (1.0f / 1024.0f) + EPS); ST[1344 + F.tid] = frsq(ST[4 + F.tid] * (1.0f / 1024.0f) + EPS); }
    __syncthreads();
    rescale_rows(F, MG, m0, 4, INP(14) + l * 1024, INP(15) + l * 1024);
    __syncthreads();
}
DI void mixer_phase(Frame& F0, int l) {
    Frame F = opaque(F0);
    if (l == 0) convert_weights(F0, 0, (256 + 128) % F.G, CV_UP, CV_ALL);
    for (int it = F.bid; it < 256 + 128; it += F.G) { if (it < 256) { if (PHEN(8)) mixer_prompt_item(F, l, it); } else { if (PHEN(9)) mixer_sample_item(F, l, it - 256); } }
}
DI void fix_phase(Frame& F0, int l) {
    Frame F = opaque(F0);
    bf16* ACT = (bf16*)(WSB(F) + WS_ACT); const float* BND = (const float*)(WSB(F) + WS_BND); const float* HS = (const float*)(WSB(F) + WS_HS);
    const float* cw = INP(19) + (size_t)l * 3 * NUP; const float* cb = INP(20) + (size_t)l * NUP; const float* stin = INP(4) + (size_t)l * 128 * 2 * NUP; float* outb = OUTB(F);
    const int gt = F.bid * 512 + F.tid, NT = F.G * 512;
    constexpr int CQ = DFF / 4;
    for (int i = gt; i < 256 * 2 * CQ; i += NT) { const int cq = i % CQ, rr = (i / CQ) & 1, blk = i / (2 * CQ), c = cq * 4; const bool first = (blk & 31) == 0;
        f32x4 act;
#pragma unroll
        for (int part = 0; part < 2; ++part) { const int cc = part * DFF + c; const f32x4 z = (f32x4){0.f, 0.f, 0.f, 0.f};
            const float* cur = BND + (size_t)blk * 4 * NUP + cc; const float* prv = BND + (size_t)(blk - 1) * 4 * NUP + cc;
            const f32x4 h0 = *(const f32x4*)cur, h1 = *(const f32x4*)(cur + NUP), hm2 = first ? z : *(const f32x4*)(prv + 2 * NUP), hm1 = first ? z : *(const f32x4*)(prv + 3 * NUP);
            const f32x4 w0 = *(const f32x4*)(cw + cc), w1 = *(const f32x4*)(cw + NUP + cc), w2 = *(const f32x4*)(cw + 2 * NUP + cc), bb = *(const f32x4*)(cb + cc);
            const f32x4 hc = rr == 0 ? (bb + w0 * hm2 + w1 * hm1 + w2 * h0) : (bb + w0 * hm1 + w1 * h0 + w2 * h1);
            if (part == 0) act = hc; else {
#pragma unroll
                for (int e = 0; e < 4; ++e) act[e] *= silu(hc[e]); } }
        v2u w; w.x = pk2(act[0], act[1]); w.y = pk2(act[2], act[3]); *(v2u*)(ACT + (size_t)(blk * 64 + rr) * DFF + c) = w; }
    for (int i = gt; i < 8 * 2 * (NUP / 4); i += NT) { const int cq = i % (NUP / 4), rr = (i / (NUP / 4)) & 1, b = i / (2 * (NUP / 4));
        *(f32x4*)(outb + O_CP + ((size_t)(l * 8 + b) * 2 + rr) * NUP + cq * 4) = *(const f32x4*)(BND + ((size_t)(b * 32 + 31) * 4 + 2 + rr) * NUP + cq * 4); }
    for (int i = gt; i < 128 * CQ; i += NT) { const int cq = i % CQ, seq = i / CQ, c = cq * 4; f32x4 act[4];
#pragma unroll
        for (int part = 0; part < 2; ++part) { const int cc = part * DFF + c; const float* st = stin + (size_t)seq * 2 * NUP + cc; const float* hs = HS + (size_t)seq * 4 * NUP + cc;
            f32x4 hp[6]; hp[0] = *(const f32x4*)st; hp[1] = *(const f32x4*)(st + NUP);
#pragma unroll
            for (int t = 0; t < 4; ++t) hp[2 + t] = *(const f32x4*)(hs + (size_t)t * NUP);
            const f32x4 w0 = *(const f32x4*)(cw + cc), w1 = *(const f32x4*)(cw + NUP + cc), w2 = *(const f32x4*)(cw + 2 * NUP + cc), bb = *(const f32x4*)(cb + cc);
            float* oc = outb + O_CS + (size_t)(l * 128 + seq) * 2 * NUP + cc; *(f32x4*)oc = hp[4]; *(f32x4*)(oc + NUP) = hp[5];
#pragma unroll
            for (int t = 0; t < 4; ++t) { const f32x4 hc = bb + w0 * hp[t] + w1 * hp[t + 1] + w2 * hp[t + 2];
                if (part == 0) act[t] = hc; else {
#pragma unroll
                    for (int e = 0; e < 4; ++e) act[t][e] *= silu(hc[e]); } } }
#pragma unroll
        for (int t = 0; t < 4; ++t) { v2u w; w.x = pk2(act[t][0], act[t][1]); w.y = pk2(act[t][2], act[t][3]); *(v2u*)(ACT + (size_t)(MP + seq * 4 + t) * DFF + c) = w; } }
}

#define XB_TMO      128
#define XB_XCNT(j)  (256  + 64 * (j))
#define XB_XSUB(j)  (1280 + 64 * (j))
#define XB_XGEN(j)  (2304 + 64 * (j))
#define XB_TOP      3328
#define XB_TOPGEN   3392
#define XCD_BAR_WORDS 3456
#define XB_SPIN_CAP (1u << 18)

__device__ __forceinline__ unsigned xb_ld(unsigned* p)              { return __hip_atomic_load(p, __ATOMIC_RELAXED, __HIP_MEMORY_SCOPE_AGENT); }
__device__ __forceinline__ unsigned xb_add(unsigned* p, unsigned v) { return __hip_atomic_fetch_add(p, v, __ATOMIC_RELAXED, __HIP_MEMORY_SCOPE_AGENT); }
__device__ __forceinline__ unsigned xb_xcc_id() { return (unsigned)__builtin_amdgcn_s_getreg((3 << 11) | 20) & 0xFu; }
#define XB_SPIN(cond, bar) do { unsigned _sp = 0; while (cond) { __builtin_amdgcn_s_sleep(1); \
    if ((++_sp & 255u) == 0u) { if (xb_ld(&(bar)[XB_TMO])) break; if (_sp > XB_SPIN_CAP) { atomicAdd(&(bar)[XB_TMO], 1u); break; } } } } while (0)

struct XcdBarrier {
    unsigned* bar; unsigned x;
    volatile LAS unsigned* st;
};

__device__ __forceinline__ XcdBarrier xcd_barrier_post(unsigned* bar, volatile LAS unsigned* st) {
    XcdBarrier b; b.bar = bar; b.x = xb_xcc_id(); b.st = st;
    if (threadIdx.x == 0) (void)xb_add(&bar[XB_XCNT(b.x)], 1u);
    return b;
}
__device__ __forceinline__ void xcd_barrier_complete(unsigned* bar, unsigned x, unsigned& nloc, unsigned& nx) {
    const unsigned G = gridDim.x * gridDim.y * gridDim.z;
    unsigned sum, cnt, mine, sp = 0u;
    for (;;) {
        sum = 0u; cnt = 0u; mine = 0u;
#pragma unroll
        for (unsigned j = 0; j < 16; ++j) { const unsigned c = xb_ld(&bar[XB_XCNT(j)]); sum += c; cnt += (c > 0u) ? 1u : 0u; mine = (j == x) ? c : mine; }
        if (sum == G) break;
        __builtin_amdgcn_s_sleep(1);
        if ((++sp & 255u) == 0u) { if (xb_ld(&bar[XB_TMO])) break; if (sp > XB_SPIN_CAP) { atomicAdd(&bar[XB_TMO], 1u); break; } }
    }
    nloc = mine > 0u ? mine : 1u; nx = cnt > 0u ? cnt : 1u;
}

__device__ __forceinline__ void xcd_barrier(const XcdBarrier& b) {
    asm volatile("s_waitcnt vmcnt(0)" ::: "memory");
    __syncthreads();
    if (threadIdx.x == 0) {
        unsigned* bar = b.bar;
        __builtin_amdgcn_s_waitcnt(0);
        unsigned nloc = b.st[0], nx = b.st[1];
        if (nloc == 0u) { xcd_barrier_complete(bar, b.x, nloc, nx); b.st[0] = nloc; b.st[1] = nx; }
        const unsigned old = xb_add(&bar[XB_XSUB(b.x)], 1u);
        const unsigned gen = old / nloc;
        if (old + 1u == (gen + 1u) * nloc) {
            __builtin_amdgcn_fence(__ATOMIC_RELEASE, "agent");
            asm volatile("s_waitcnt vmcnt(0)" ::: "memory");
            const unsigned og = xb_add(&bar[XB_TOP], 1u);
            const unsigned tg = og / nx;
            if (og + 1u == (tg + 1u) * nx) xb_add(&bar[XB_TOPGEN], 1u);
            else XB_SPIN(xb_ld(&bar[XB_TOPGEN]) == tg, bar);
            __builtin_amdgcn_fence(__ATOMIC_ACQUIRE, "agent");
            xb_add(&bar[XB_XGEN(b.x)], 1u);
            asm volatile("s_waitcnt vmcnt(0)" ::: "memory");
        } else {
            XB_SPIN(xb_ld(&bar[XB_XGEN(b.x)]) == gen, bar);
            __builtin_amdgcn_fence(__ATOMIC_ACQUIRE, "agent");
            asm volatile("s_waitcnt vmcnt(0)" ::: "memory");
        }
    }
    __syncthreads();
}

__global__ void __launch_bounds__(512, 2) mk_fwd(Args args) {
    extern __shared__ __attribute__((aligned(16))) unsigned char lds[];
    Frame F;
    F.lds = (LAS unsigned char*)lds; F.tid = 0; F.lane = 0; F.wave = __builtin_amdgcn_readfirstlane((int)threadIdx.x >> 6); F.G = gridDim.x; F.bid = blockIdx.x;
    F.out = args.out; F.ws = args.ws;
    const int lo = args.ph_lo, hi = args.ph_hi;
    volatile LAS unsigned* bst = (volatile LAS unsigned*)(F.lds + LDS_BYTES - 64);
    if (threadIdx.x < 16) bst[threadIdx.x] = 0u;
    __syncthreads();
    (void)xcd_barrier_post((unsigned*)(args.ws) + CW_BAR, bst);
#define IN(k) (lo <= (k) && (k) < hi)
#define SEAMX() do { XcdBarrier b_; b_.bar = (unsigned*)WSB(F) + CW_BAR; b_.x = xb_xcc_id(); b_.st = (volatile LAS unsigned*)(F.lds + LDS_BYTES - 64); xcd_barrier(b_); } while (0)
#define SEAM(k) do { if (IN(k) && IN((k) + 1)) { if ((k) == 0) cg::this_grid().sync(); else { XcdBarrier b_; b_.bar = (unsigned*)WSB(F) + CW_BAR; b_.x = xb_xcc_id(); b_.st = (volatile LAS unsigned*)(F.lds + LDS_BYTES - 64); xcd_barrier(b_); } } } while (0)
    if (PHEN(0) && IN(0)) { prologue(F); } SEAM(0);
#ifdef MK_XSYNC
#pragma unroll 1
    for (int xs_ = 0; xs_ < MK_XSYNC; ++xs_) cg::this_grid().sync();
#endif
#pragma unroll 1
    for (int l = 0; l < DEPTH; ++l) {
        const int p0 = 1 + 8 * l;
        if (PHEN(1) && IN(p0)) {
            zero_rss(F, 0);
            pg8::Gemm g{(const bf16*)(WSB(F) + WS_XN), (const bf16*)(WSB(F) + WS_WIN + l * 13 * MiB), MT, NIN, DM, F.wave}; pg8::StaticOrder S; S.init(MT, NIN, F.G, F.bid, DM / 64);
            EpiIn E{WSB(F), OUTB(F), l};
            pg8::gemm_phase<EpiIn, pg8::StaticOrder, true, true>(F.lds, g, S, E);
            if (l == 0) convert_weights(F, 0, ((MT / 256) * (NIN / 256)) % F.G, CV_O, CV_UP);
        } SEAM(p0);
        if (PHEN(2) && IN(p0 + 1)) { mixer_phase(F, l); } SEAM(p0 + 1);
        if (PHEN(3) && IN(p0 + 2)) {
            pg8::Gemm g{(const bf16*)(WSB(F) + WS_MG), (const bf16*)(WSB(F) + WS_WO + l * 8 * MiB), MT, DM, DM, F.wave}; pg8::SplitOrder S; S.init(MP, MS, DM, F.G, F.bid, DM / 64, NSPLIT);
            EpiRes E{OUTB(F), WSB(F), 0, false};
            pg8::gemm_phase<EpiRes, pg8::SplitOrder, true, true>(F.lds, g, S, E);
        } SEAM(p0 + 2);
        if (PHEN(4) && IN(p0 + 3)) { reduce_phase(F, 0, false); } SEAM(p0 + 3);
        if (PHEN(5) && IN(p0 + 4)) {
            zero_rss(F, 1);
            pg8::Gemm g{(const bf16*)(WSB(F) + WS_XN), (const bf16*)(WSB(F) + WS_WUP + l * 43 * MiB), MT, NUP, DM, F.wave}; pg8::StaticOrder S; S.init(MT, NUP, F.G, F.bid, DM / 64);
            EpiUp E{WSB(F), l};
            pg8::gemm_phase<EpiUp, pg8::StaticOrder, true, true>(F.lds, g, S, E);
            if (l == 0) convert_weights(F, 1, ((MT / 256) * (NUP / 256)) % F.G, 0, CV_ALL);
        } SEAM(p0 + 4);
        if (PHEN(6) && IN(p0 + 5)) { fix_phase(F, l); } SEAM(p0 + 5);
        if (PHEN(7) && IN(p0 + 6)) {
            pg8::Gemm g{(const bf16*)(WSB(F) + WS_ACT), (const bf16*)(WSB(F) + WS_WDN + l * 22 * MiB), MT, DM, DFF, F.wave}; pg8::SplitOrder S; S.init(MP, MS, DM, F.G, F.bid, DFF / 64, NSPLIT);
            EpiRes E{OUTB(F), WSB(F), 1, l + 1 == DEPTH};
            pg8::gemm_phase<EpiRes, pg8::SplitOrder, true, true>(F.lds, g, S, E);
        } SEAM(p0 + 6);
        if (PHEN(4) && IN(p0 + 7)) { reduce_phase(F, 1, l + 1 == DEPTH); } SEAM(p0 + 7);
    }
#undef IN
#undef SEAM
}

extern "C" void kernel_launch(void* const* d_in, const int* in_sizes, int n_in, void* d_out, int out_size, void* d_ws, size_t ws_size, hipStream_t stream) {
    static int grid = 0;
    if (grid == 0) {
        if (n_in != 22 || (size_t)out_size != O_END || ws_size < WS_END) { fprintf(stderr, "kernel_launch: unexpected shapes (n_in %d out %d ws %zu)\n", n_in, out_size, ws_size); grid = -1; return; }
        if (hipFuncSetAttribute((const void*)mk_fwd, hipFuncAttributeMaxDynamicSharedMemorySize, LDS_BYTES) != hipSuccess) { fprintf(stderr, "hipFuncSetAttribute failed\n"); grid = -1; return; }
        int dev = 0, cus = 0, per_cu = 0;
        (void)hipGetDevice(&dev); (void)hipDeviceGetAttribute(&cus, hipDeviceAttributeMultiprocessorCount, dev);
        (void)hipOccupancyMaxActiveBlocksPerMultiprocessor(&per_cu, (const void*)mk_fwd, 512, LDS_BYTES);
        if (per_cu < 1) per_cu = 1;
        grid = cus > 0 ? cus : 256;
        (void)hipGetLastError();
    }
    if (grid < 0) return;
    if (hipMemsetAsync(d_ws, 0, 65536, stream) != hipSuccess) { fprintf(stderr, "memset failed\n"); return; }
    Args a{};
    for (int i = 0; i < 22; ++i) a.in[i] = (const float*)d_in[i];
    a.out = (float*)d_out; a.ws = (unsigned char*)d_ws;
    for (int t = 0; t < 8; ++t) a.rep[t] = 1 + (((MK_DUP) >> t) & 1) * (t == 7 ? 2 : 1);
    constexpr int NL = MK_N_LAUNCHES;
    if (NL == 1) {
        a.ph_lo = 0; a.ph_hi = 1 + 8 * DEPTH;
        void* kargs[] = {&a};
        hipError_t e = hipLaunchCooperativeKernel((const void*)mk_fwd, dim3(grid), dim3(512), kargs, LDS_BYTES, stream);
        if (e != hipSuccess) fprintf(stderr, "cooperative launch failed: %s (grid %d)\n", hipGetErrorString(e), grid);
    } else {
        for (int p = 0; p < 1 + 8 * DEPTH; ++p) { if (p == 8 * DEPTH) break;
            a.ph_lo = p; a.ph_hi = p + 1;
            hipLaunchKernelGGL(mk_fwd, dim3(grid), dim3(512), LDS_BYTES, stream, a); }
    }
}
```

```cpp
#include <hip/hip_runtime.h>
#include <hip/hip_cooperative_groups.h>
#include <cstdio>
#include <cstdint>
namespace cg = cooperative_groups;
#define MK_DUP 0
#define MK_MIXDUP 0
namespace pg8 {
#define PG8_LAS __attribute__((address_space(3)))
typedef unsigned short bf16_t;
typedef short bf16x8 __attribute__((ext_vector_type(8)));
typedef float f32x4 __attribute__((ext_vector_type(4)));
typedef unsigned u32x4 __attribute__((ext_vector_type(4)));
constexpr int BM = 256, BK = 64, HALF = 128, HTB = HALF * BK * 2  , STAGE_BYTES = 8 * HTB, NXCD = 8, WGM = 8;

__host__ __device__ __forceinline__ int lds_byte(int r, int c) { const int st = (r >> 4) * 2 + (c >> 5), rr = r & 15, cc = c & 31, ob = rr * 64 + cc * 2; return st * 1024 + (ob ^ (((ob >> 9) & 1) << 5)); }
__host__ __device__ __forceinline__ void stage_rc(int b, int& R, int& C) { const int st = b / 1024, sb = b % 1024, swz = sb ^ (((sb >> 9) & 1) << 5); R = (st >> 1) * 16 + swz / 64; C = (st & 1) * 32 + (swz % 64) / 2; }
__host__ __device__ __forceinline__ int perm32(int rho) { const int n = rho >> 4, i = rho & 15; return 8 * (i >> 2) + 4 * n + (i & 3); }

struct Unit { int pm, pn, k0, nt, sp; };
struct Gemm { const bf16_t* A; const bf16_t* Bt; int M, N, K, wave; };

struct StaticOrder {
    int nM, nN, nwg, G, c, ntK;
    __host__ __device__ void init(int M, int N, int G_, int c_, int ntK_) { nM = M / BM; nN = N / BM; nwg = nM * nN; G = G_; c = c_; ntK = ntK_; }
    __host__ __device__ bool next(int i, Unit& u) const {
        const long L = (long)i * G + c; if (L >= nwg) return false;
        int wgid = (int)L; { const int q = nwg / NXCD, r = nwg % NXCD, xcd = wgid % NXCD, off = wgid / NXCD; wgid = (xcd < r ? xcd * (q + 1) : r * (q + 1) + (xcd - r) * q) + off; }
        const int nig = WGM * nN, gid = wgid / nig, fm = gid * WGM, gsz = (nM - fm) < WGM ? (nM - fm) : WGM;
        u.pm = fm + ((wgid % nig) % gsz); u.pn = (wgid % nig) / gsz; u.k0 = 0; u.nt = ntK; u.sp = 0; return true;
    }
    __device__ __forceinline__ void a_ready(const Unit&) const {}
    __device__ __forceinline__ void done(const Unit&) const {}
};


struct SplitOrder {
    StaticOrder main; int nMmain, nMtail, nsplit;
    __host__ __device__ void init(int Mmain, int Mtail, int N, int G_, int c_, int ntK_, int nsplit_) { main.init(Mmain, N, G_, c_, ntK_); nMmain = Mmain / BM; nMtail = Mtail / BM; nsplit = nsplit_; }
    __host__ __device__ bool next(int i, Unit& u) const {
        const long L = (long)i * main.G + main.c;
        if (L < main.nwg) return main.next(i, u);
        const int j = (int)(L - main.nwg), nu = nMtail * main.nN; if (j >= nu * nsplit) return false;
        const int un = j % nu, sp = j / nu, iters = main.ntK / 2, i0 = (iters * sp) / nsplit, i1 = (iters * (sp + 1)) / nsplit;
        u.pm = nMmain + un / main.nN; u.pn = un % main.nN; u.k0 = 2 * i0; u.nt = 2 * (i1 - i0); u.sp = sp; return true;
    }
    __device__ __forceinline__ void a_ready(const Unit&) const {}
    __device__ __forceinline__ void done(const Unit&) const {}
};
template <class Epi, class Sched, bool ALIGN_EPI = false, bool SP2 = false>
__device__ __forceinline__ void gemm_phase(PG8_LAS unsigned char* lds, const Gemm g, const Sched& S, const Epi& E) {
    int tid_o = (int)__builtin_amdgcn_mbcnt_hi(~0u, __builtin_amdgcn_mbcnt_lo(~0u, 0u)); asm volatile("" : "+v"(tid_o)); tid_o += 64 * g.wave;
    const int tid = tid_o, wid = __builtin_amdgcn_readfirstlane(tid >> 6), lane = tid & 63, wr = wid >> 2, wc = wid & 3, fr = lane & 15, fq = lane >> 4;
    const int K = g.K;
    unsigned voffA[2], voffB[2];
#pragma unroll
    for (int i = 0; i < 2; ++i) { int R, C; stage_rc(tid * 16 + i * 8192, R, C); const int Rb = Epi::PERM ? ((R & ~31) + perm32(R & 31)) : R;
        const int Ra = (R & ~63) | ((R & 15) << 2) | ((R >> 4) & 3);
        voffA[i] = (unsigned)(Ra * K + C) * 2u; voffB[i] = (unsigned)(Rb * K + C) * 2u; }
    const size_t kstep = (size_t)(BK * 2);
    const size_t hstep = (size_t)HALF * K * 2;
    const size_t tstep = 2 * hstep;
    const unsigned ldsw = (unsigned)wid * 1024u;
    const int aoff = lds_byte(wr * 64 + fr, fq * 8), boff = lds_byte(wc * 32 + fr, fq * 8);
#define PG8_SA(b, h) (((b) * 2 + (h)) * HTB)
#define PG8_SB(b, h) ((4 + (b) * 2 + (h)) * HTB)
#define PG8_STAGE(bufoff, gbase, voff) do { _Pragma("unroll") for (int _i = 0; _i < 2; ++_i) \
        __builtin_amdgcn_global_load_lds((const unsigned*)((const char*)(gbase) + (voff)[_i]), (PG8_LAS unsigned*)(lds + (bufoff) + ldsw + _i * 8192), 16, 0, 0); } while (0)
#define PG8_LDA(dst, b, h) do { _Pragma("unroll") for (int m = 0; m < 4; ++m) _Pragma("unroll") for (int k = 0; k < 2; ++k) dst[m][k] = *(const PG8_LAS bf16x8*)(lds + PG8_SA(b, h) + aoff + m * 2048 + k * 1024); } while (0)
#define PG8_LDB(dst, b, h) do { _Pragma("unroll") for (int n = 0; n < 2; ++n) _Pragma("unroll") for (int k = 0; k < 2; ++k) dst[n][k] = *(const PG8_LAS bf16x8*)(lds + PG8_SB(b, h) + boff + n * 2048 + k * 1024); } while (0)
#define PG8_MMA(ai, bj, At, Bt) do { __builtin_amdgcn_s_setprio(1); _Pragma("unroll") for (int m = 0; m < 4; ++m) _Pragma("unroll") for (int n = 0; n < 2; ++n) _Pragma("unroll") for (int k = 0; k < 2; ++k) \
        acc[ai][bj][m][n] = __builtin_amdgcn_mfma_f32_16x16x32_bf16(Bt[n][k], At[m][k], acc[ai][bj][m][n], 0, 0, 0); __builtin_amdgcn_s_setprio(0); } while (0)
#define PG8_WAIT_V(n) asm volatile("s_waitcnt vmcnt(" #n ")" ::: "memory")
#define PG8_WAIT_L(n) asm volatile("s_waitcnt lgkmcnt(" #n ")" ::: "memory")
#define PG8_BAR __builtin_amdgcn_s_barrier()
#define PG8_SCHED __builtin_amdgcn_sched_barrier(0)
    Unit cur, nxt; int ui = 0;
    if (!S.next(0, cur)) return;
    f32x4 acc[2][2][4][2];
#pragma unroll
    for (int a = 0; a < 2; ++a)
#pragma unroll
        for (int b = 0; b < 2; ++b)
#pragma unroll
            for (int m = 0; m < 4; ++m)
#pragma unroll
                for (int n = 0; n < 2; ++n) acc[a][b][m][n] = (f32x4){0.f, 0.f, 0.f, 0.f};
    bf16x8 At[4][2], B0[2][2], B1[2][2];
    const char* cA = (const char*)g.A + (size_t)cur.pm * tstep + (size_t)cur.k0 * kstep; const char* cB = (const char*)g.Bt + (size_t)cur.pn * tstep + (size_t)cur.k0 * kstep;
    S.a_ready(cur);
    if constexpr (SP2) {
        PG8_STAGE(PG8_SB(0, 0), cB, voffB); PG8_STAGE(PG8_SB(0, 1), cB + hstep, voffB); PG8_STAGE(PG8_SA(0, 0), cA, voffA); PG8_STAGE(PG8_SA(0, 1), cA + hstep, voffA);
        if (wr == 1) PG8_BAR;
        PG8_WAIT_V(2); PG8_BAR;
        PG8_STAGE(PG8_SB(1, 0), cB + kstep, voffB); PG8_STAGE(PG8_SA(1, 0), cA + kstep, voffA); PG8_STAGE(PG8_SB(1, 1), cB + hstep + kstep, voffB);
        PG8_WAIT_V(6); PG8_BAR;
    } else {
        PG8_STAGE(PG8_SB(0, 0), cB, voffB); PG8_STAGE(PG8_SA(0, 0), cA, voffA); PG8_STAGE(PG8_SB(0, 1), cB + hstep, voffB); PG8_STAGE(PG8_SA(0, 1), cA + hstep, voffA);
        if (wr == 1) PG8_BAR;
        PG8_WAIT_V(4); PG8_BAR;
        PG8_STAGE(PG8_SB(1, 0), cB + kstep, voffB); PG8_STAGE(PG8_SA(1, 0), cA + kstep, voffA); PG8_STAGE(PG8_SB(1, 1), cB + hstep + kstep, voffB);
        PG8_WAIT_V(6); PG8_BAR;
    }
    for (;;) {
        const bool has_next = S.next(ui + 1, nxt);
        const char* nA = has_next ? (const char*)g.A + (size_t)nxt.pm * tstep + (size_t)nxt.k0 * kstep : cA; const char* nB = has_next ? (const char*)g.Bt + (size_t)nxt.pn * tstep + (size_t)nxt.k0 * kstep : cB;
        const int nt = cur.nt;
        for (int t = 0; t < nt; t += 2) {
            const bool last = (t == nt - 2);
            const char* a1 = cA + (size_t)(t + 1) * kstep;
            const char* a2 = last ? nA : cA + (size_t)(t + 2) * kstep; const char* b2 = last ? nB : cB + (size_t)(t + 2) * kstep;
            const char* a3 = a2 + kstep; const char* b3 = b2 + kstep;
            if (last && has_next) S.a_ready(nxt);
            if constexpr (SP2) {
            PG8_LDB(B0, 0, 0); PG8_LDB(B1, 0, 1); PG8_SCHED; PG8_LDA(At, 0, 0); PG8_STAGE(PG8_SA(1, 1), a1 + hstep, voffA);
            PG8_WAIT_V(8); PG8_WAIT_L(0); PG8_BAR; PG8_MMA(0, 0, At, B0); PG8_MMA(0, 1, At, B1); PG8_BAR; PG8_SCHED;
            PG8_LDA(At, 0, 1); PG8_STAGE(PG8_SB(0, 0), b2, voffB); PG8_STAGE(PG8_SB(0, 1), b2 + hstep, voffB); PG8_STAGE(PG8_SA(0, 0), a2, voffA);
            PG8_WAIT_V(8); PG8_WAIT_L(0); PG8_BAR; PG8_MMA(1, 0, At, B0); PG8_MMA(1, 1, At, B1); PG8_BAR; PG8_SCHED;
            PG8_LDB(B0, 1, 0); PG8_LDB(B1, 1, 1); PG8_SCHED; PG8_LDA(At, 1, 0); PG8_STAGE(PG8_SA(0, 1), a2 + hstep, voffA);
            PG8_WAIT_V(8); PG8_WAIT_L(0); PG8_BAR; PG8_MMA(0, 0, At, B0); PG8_MMA(0, 1, At, B1); PG8_BAR; PG8_SCHED;
            PG8_LDA(At, 1, 1); PG8_STAGE(PG8_SB(1, 0), b3, voffB); PG8_STAGE(PG8_SB(1, 1), b3 + hstep, voffB); PG8_STAGE(PG8_SA(1, 0), a3, voffA);
            PG8_WAIT_V(8); PG8_WAIT_L(0); PG8_BAR; PG8_MMA(1, 0, At, B0); PG8_MMA(1, 1, At, B1); PG8_BAR; PG8_SCHED;
            } else {
            PG8_LDB(B0, 0, 0); PG8_SCHED; PG8_LDA(At, 0, 0); PG8_STAGE(PG8_SA(1, 1), a1 + hstep, voffA);
            PG8_WAIT_L(8); PG8_BAR; PG8_WAIT_L(0); PG8_MMA(0, 0, At, B0); PG8_BAR; PG8_SCHED;
            PG8_LDB(B1, 0, 1); PG8_STAGE(PG8_SB(0, 0), b2, voffB);
            PG8_BAR; PG8_WAIT_L(0); PG8_MMA(0, 1, At, B1); PG8_BAR;
            PG8_LDA(At, 0, 1); PG8_STAGE(PG8_SA(0, 0), a2, voffA);
            PG8_BAR; PG8_WAIT_L(0); PG8_MMA(1, 0, At, B0); PG8_BAR; PG8_SCHED;
            PG8_STAGE(PG8_SB(0, 1), b2 + hstep, voffB);
            PG8_WAIT_V(6); PG8_BAR; PG8_MMA(1, 1, At, B1); PG8_BAR;
            PG8_LDB(B0, 1, 0); PG8_SCHED; PG8_LDA(At, 1, 0); PG8_STAGE(PG8_SA(0, 1), a2 + hstep, voffA);
            PG8_WAIT_L(8); PG8_BAR; PG8_WAIT_L(0); PG8_MMA(0, 0, At, B0); PG8_BAR; PG8_SCHED;
            PG8_LDB(B1, 1, 1); PG8_STAGE(PG8_SB(1, 0), b3, voffB);
            PG8_BAR; PG8_WAIT_L(0); PG8_MMA(0, 1, At, B1); PG8_BAR;
            PG8_LDA(At, 1, 1); PG8_STAGE(PG8_SA(1, 0), a3, voffA);
            PG8_BAR; PG8_WAIT_L(0); PG8_MMA(1, 0, At, B0); PG8_BAR; PG8_SCHED;
            PG8_STAGE(PG8_SB(1, 1), b3 + hstep, voffB);
            PG8_WAIT_V(6); PG8_BAR; PG8_MMA(1, 1, At, B1); PG8_BAR;
            }
        }
        if constexpr (ALIGN_EPI) { if (wr == 0) PG8_BAR; }
        if constexpr (!Epi::AFTER_DRAIN) { E(acc, cur, wr, wc, fr, fq); S.done(cur); }
        if (!has_next) break;
#pragma unroll
        for (int a = 0; a < 2; ++a)
#pragma unroll
            for (int b = 0; b < 2; ++b)
#pragma unroll
                for (int m = 0; m < 4; ++m)
#pragma unroll
                    for (int n = 0; n < 2; ++n) acc[a][b][m][n] = (f32x4){0.f, 0.f, 0.f, 0.f};
        cur = nxt; cA = nA; cB = nB; ++ui;
        if constexpr (ALIGN_EPI) { if (wr == 1) PG8_BAR; }
    }
    PG8_WAIT_V(0);
    if constexpr (!ALIGN_EPI) { if (wr == 0) PG8_BAR; }
    PG8_BAR;
    if constexpr (Epi::AFTER_DRAIN) { E.fused(acc, cur, wr, wc, fr, fq, lds, wid, lane); S.done(cur); }
#undef PG8_SA
#undef PG8_SB
#undef PG8_STAGE
#undef PG8_LDA
#undef PG8_LDB
#undef PG8_MMA
#undef PG8_WAIT_V
#undef PG8_WAIT_L
#undef PG8_BAR
#undef PG8_SCHED
}
}

#ifndef MK_N_LAUNCHES
#define MK_N_LAUNCHES 1
#endif
#ifndef MK_PHMASK
#define MK_PHMASK 0x3ff
#endif
#define PHEN(t) (((MK_PHMASK) >> (t)) & 1)
#ifndef MK_DUP
#define MK_DUP 0
#endif
#ifndef MK_MIXDUP
#define MK_MIXDUP 0
#endif
#define REP(t, l) _Pragma("unroll 1") for (int rep_ = 0, nrep_ = ((l) == 0 ? KARG_I(200 + 4 * (t)) : 1); rep_ < nrep_; ++rep_)
constexpr int DM = 2048, MP = 16384, MS = 512, MT = MP + MS, SEQ = 2048, NIN = 3328, DFF = 5504, NUP = 11008;
constexpr int DEPTH = 2, NPH = 16;
constexpr float EPS = 1e-6f, LOG2E = 1.4426950408889634f;
constexpr size_t MiB = 1u << 20;
constexpr size_t SZ_WIN = (size_t)NIN * DM * 2, SZ_WO = (size_t)DM * DM * 2, SZ_WUP = (size_t)NUP * DM * 2, SZ_WDN = (size_t)DM * DFF * 2;
constexpr size_t WS_WIN = 1 * MiB, WS_WO = WS_WIN + 2 * 13 * MiB, WS_WUP = WS_WO + 2 * 8 * MiB, WS_WDN = WS_WUP + 2 * 43 * MiB;
constexpr size_t WS_XN = WS_WDN + 2 * 22 * MiB;
constexpr size_t WS_ACT = WS_XN + 66 * MiB;
constexpr size_t WS_Q = WS_ACT, WS_U = WS_Q + 33 * MiB, WS_VS = WS_U + 33 * MiB, WS_K = WS_VS + 33 * MiB, WS_V = WS_K + 5 * MiB, WS_MG = WS_V + 5 * MiB;
constexpr size_t WS_BND = WS_ACT + 178 * MiB;
constexpr size_t WS_HS = WS_BND + 43 * MiB;
constexpr size_t WS_PART = WS_HS + 22 * MiB;
constexpr size_t WS_END = WS_PART + 32 * MiB;
constexpr size_t WS_RSS = 256 * 1024;
constexpr int NSPLIT = 8;
static_assert(WS_MG + 66 * MiB <= WS_BND && SZ_WIN <= 13 * MiB && SZ_WO <= 8 * MiB && SZ_WUP <= 43 * MiB && SZ_WDN <= 22 * MiB, "ws map");
constexpr size_t O_YS = (size_t)MP * DM, O_KP = O_YS + (size_t)MS * DM, O_VP = O_KP + 262144, O_CP = O_VP + 262144, O_KS = O_CP + 352256, O_VSO = O_KS + 4194304,
                 O_CS = O_VSO + 4194304, O_SV = O_CS + 5636096, O_END = O_SV + 1048576;
constexpr int LDS_BYTES = 147456;
constexpr int CW_BAR = 4096;
constexpr int KS_OFF = 0, KS_STRIDE = 144, VT_OFF = 55296, VT_STRIDE = 400, ST_OFF = 110592;
constexpr int SG_WAVE = 32 * 272;

#define GAS __attribute__((address_space(1)))
#define LAS __attribute__((address_space(3)))
#define RLX_AGENT __ATOMIC_RELAXED, __HIP_MEMORY_SCOPE_AGENT
#define DI __device__ __forceinline__
typedef unsigned short bf16;
typedef unsigned v4u __attribute__((ext_vector_type(4)));
typedef unsigned v2u __attribute__((ext_vector_type(2)));
typedef float f32x4 __attribute__((ext_vector_type(4)));
typedef float f32x16 __attribute__((ext_vector_type(16)));
typedef short bf16x8 __attribute__((ext_vector_type(8)));
typedef short s16x4 __attribute__((ext_vector_type(4)));
#define MFMA32(a, b, c) __builtin_amdgcn_mfma_f32_32x32x16_bf16((a), (b), (c), 0, 0, 0)
#define LDS_WAIT() asm volatile("s_waitcnt lgkmcnt(0)" ::: "memory")

DI unsigned pk2(float lo, float hi) { unsigned r; asm volatile("v_cvt_pk_bf16_f32 %0, %1, %2" : "=v"(r) : "v"(lo), "v"(hi)); return r; }
DI float bflo(unsigned w) { return __uint_as_float(w << 16); }
DI float bfhi(unsigned w) { return __uint_as_float(w & 0xffff0000u); }
DI float fexp2(float x) { return __builtin_amdgcn_exp2f(x); }
DI float frcp(float x) { return __builtin_amdgcn_rcpf(x); }
DI float frsq(float x) { return __builtin_amdgcn_rsqf(x); }
DI float gelu_t(float x) { const float t = x * (1.0f + 0.044715f * x * x); return x * frcp(1.0f + fexp2(-2.302208198f * t)); }
DI float silu(float x) { return x * frcp(1.0f + fexp2(-LOG2E * x)); }
DI float wave_sum(float v) {
#pragma unroll
    for (int o = 1; o < 64; o <<= 1) v += __shfl_xor(v, o);
    return v;
}
DI int crow(int reg, int h) { return (reg & 3) + 8 * (reg >> 2) + 4 * h; }
DI float dpp_ror1(float s) { return __builtin_bit_cast(float, __builtin_amdgcn_update_dpp(0, __builtin_bit_cast(int, s), 0x121, 0xf, 0xf, false)); }
DI float dpp_ror2(float s) { return __builtin_bit_cast(float, __builtin_amdgcn_update_dpp(0, __builtin_bit_cast(int, s), 0x122, 0xf, 0xf, false)); }
DI float dpp_shr1(float o, float s) { return __builtin_bit_cast(float, __builtin_amdgcn_update_dpp(__builtin_bit_cast(int, o), __builtin_bit_cast(int, s), 0x111, 0xf, 0xf, false)); }
DI float dpp_shr2(float o, float s) { return __builtin_bit_cast(float, __builtin_amdgcn_update_dpp(__builtin_bit_cast(int, o), __builtin_bit_cast(int, s), 0x112, 0xf, 0xf, false)); }

struct Args { const float* in[22]; float* out; unsigned char* ws; int ph_lo, ph_hi; int rep[8]; };
struct Frame {
    LAS unsigned char* lds; int tid, lane, wave, G, bid;
    float* out; unsigned char* ws;
};
DI const float* INP(int k) { const char __attribute__((address_space(4)))* p = (const char __attribute__((address_space(4)))*)__builtin_amdgcn_kernarg_segment_ptr(); asm volatile("" : "+s"(p)); return (const float*)(((const GAS float* const __attribute__((address_space(4)))*)p)[k]); }
DI Frame opaque(const Frame& F0) { Frame F = F0; int ln = (int)__builtin_amdgcn_mbcnt_hi(~0u, __builtin_amdgcn_mbcnt_lo(~0u, 0u)); asm volatile("" : "+v"(ln)); F.lane = ln; F.tid = F0.wave * 64 + ln; return F; }
DI int KARG_I(int byteoff) { const char __attribute__((address_space(4)))* p = (const char __attribute__((address_space(4)))*)__builtin_amdgcn_kernarg_segment_ptr(); asm volatile("" : "+s"(p)); return *(const int __attribute__((address_space(4)))*)(p + byteoff); }
DI unsigned char* WSB(const Frame& F) { GAS unsigned char* p = (GAS unsigned char*)F.ws; asm volatile("" : "+s"(p)); return (unsigned char*)p; }
DI float* OUTB(const Frame& F) { GAS float* p = (GAS float*)F.out; asm volatile("" : "+s"(p)); return (float*)p; }

struct EpiIn {
    static constexpr bool PERM = false, AFTER_DRAIN = false;
    unsigned char* ws; float* out; int l;
    DI void operator()(const f32x4 (&acc)[2][2][4][2], const pg8::Unit& u, int wr, int wc, int fr, int fq) const {
        bf16 *Q = (bf16*)(ws + WS_Q), *Kb = (bf16*)(ws + WS_K), *Vb = (bf16*)(ws + WS_V), *U = (bf16*)(ws + WS_U), *VS = (bf16*)(ws + WS_VS);
        const float *gq = INP(7) + l * 64, *gk = INP(8) + l * 64; const float* rss = (const float*)(ws + WS_RSS) + MT;
        float *kwp = out + O_KP + (size_t)l * 131072, *vwp = out + O_VP + (size_t)l * 131072, *kws = out + O_KS + (size_t)l * 2097152, *vws = out + O_VSO + (size_t)l * 2097152;
        const int pn = u.pn;
        const bool isq = pn < 4, iskv = pn == 4, isk = iskv && wc < 2;
        f32x4 g[2][2];
        const float* gp = isq ? gq : gk;
#pragma unroll
        for (int bj = 0; bj < 2; ++bj)
#pragma unroll
            for (int n = 0; n < 2; ++n) g[bj][n] = (isq || isk) ? *(const f32x4*)(gp + 32 * bj + 8 * fq + 4 * n) : (f32x4){1.f, 1.f, 1.f, 1.f};
        f32x4 rsq4[2];
#pragma unroll
        for (int ai = 0; ai < 2; ++ai) rsq4[ai] = *(const f32x4*)(rss + u.pm * 256 + ai * 128 + wr * 64 + fr * 4);
        bf16* obase; int ld;
        if (isq) { obase = Q + pn * 256 + wc * 64; ld = 1024; }
        else if (iskv) { obase = (wc < 2 ? Kb : Vb) + (wc & 1) * 64; ld = 128; }
        else if (pn < 9) { obase = U + (pn - 5) * 256 + wc * 64; ld = 1024; }
        else { obase = VS + (pn - 9) * 256 + wc * 64; ld = 1024; }
#pragma unroll
        for (int ai = 0; ai < 2; ++ai)
#pragma unroll
            for (int m = 0; m < 4; ++m) {
                const int row = u.pm * 256 + ai * 128 + wr * 64 + fr * 4 + m;
                const float rsx = frsq(rsq4[ai][m] * (1.0f / DM) + EPS);
                f32x4 v[2][2];
#pragma unroll
                for (int bj = 0; bj < 2; ++bj)
#pragma unroll
                    for (int n = 0; n < 2; ++n) v[bj][n] = acc[ai][bj][m][n] * rsx;
                if (isq || isk) {
                    float ss = 0.f;
#pragma unroll
                    for (int bj = 0; bj < 2; ++bj)
#pragma unroll
                        for (int n = 0; n < 2; ++n) { const f32x4 x = v[bj][n]; ss += (x[0] * x[0] + x[1] * x[1]) + (x[2] * x[2] + x[3] * x[3]); }
                    ss += __shfl_xor(ss, 16); ss += __shfl_xor(ss, 32);
                    const float rs = frsq(ss * (1.0f / 64.0f) + EPS);
#pragma unroll
                    for (int bj = 0; bj < 2; ++bj)
#pragma unroll
                        for (int n = 0; n < 2; ++n) v[bj][n] = v[bj][n] * rs * g[bj][n];
                } else if (!iskv) {
#pragma unroll
                    for (int bj = 0; bj < 2; ++bj)
#pragma unroll
                        for (int n = 0; n < 2; ++n)
#pragma unroll
                            for (int e = 0; e < 4; ++e) v[bj][n][e] = gelu_t(v[bj][n][e]);
                }
                bf16* rowp = obase + (size_t)row * ld + 8 * fq;
#pragma unroll
                for (int bj = 0; bj < 2; ++bj) { v4u w; w.x = pk2(v[bj][0][0], v[bj][0][1]); w.y = pk2(v[bj][0][2], v[bj][0][3]); w.z = pk2(v[bj][1][0], v[bj][1][1]); w.w = pk2(v[bj][1][2], v[bj][1][3]);
                    *(v4u*)(rowp + 32 * bj) = w; }
                if (iskv) {
                    float* wb = nullptr;
                    if (row < MP) { const int t = row & (SEQ - 1); if (t >= SEQ - 128) wb = (wc < 2 ? kwp : vwp) + ((size_t)((row >> 11) * 128 + (t - (SEQ - 128))) * 2 + (wc & 1)) * 64; }
                    else { const int sr = row - MP; wb = (wc < 2 ? kws : vws) + ((size_t)((sr >> 2) * 128 + 124 + (sr & 3)) * 2 + (wc & 1)) * 64; }
                    if (wb) {
#pragma unroll
                        for (int bj = 0; bj < 2; ++bj)
#pragma unroll
                            for (int n = 0; n < 2; ++n) *(f32x4*)(wb + 32 * bj + 8 * fq + 4 * n) = v[bj][n];
                    }
                }
            }
    }
};
struct EpiRes {
    static constexpr bool PERM = false, AFTER_DRAIN = false;
    float* out; unsigned char* ws; int rsel; bool fin;
    DI void operator()(const f32x4 (&acc)[2][2][4][2], const pg8::Unit& u, int wr, int wc, int fr, int fq) const {
        const int col0 = u.pn * 256 + wc * 32 + 8 * fq;
        if (u.pm >= MP / 256) {
            float* P = (float*)(ws + WS_PART) + (size_t)u.sp * MS * DM;
#pragma unroll
            for (int ai = 0; ai < 2; ++ai)
#pragma unroll
                for (int m = 0; m < 4; ++m) { const size_t off = (size_t)((u.pm - MP / 256) * 256 + ai * 128 + wr * 64 + fr * 4 + m) * DM + col0;
#pragma unroll
                    for (int bj = 0; bj < 2; ++bj)
#pragma unroll
                        for (int n = 0; n < 2; ++n) *(f32x4*)(P + off + bj * 128 + n * 4) = acc[ai][bj][m][n]; }
            return;
        }
        bf16* XN = (bf16*)(ws + WS_XN); float* rss = (float*)(ws + WS_RSS) + rsel * MT;
#pragma unroll
        for (int ai = 0; ai < 2; ++ai) {
            v4u rw[1][4][2];
#pragma unroll
            for (int m = 0; m < 4; ++m)
#pragma unroll
                for (int bj = 0; bj < 2; ++bj) rw[0][m][bj] = *(const v4u*)(XN + (size_t)(u.pm * 256 + ai * 128 + wr * 64 + fr * 4 + m) * DM + col0 + bj * 128);
            asm volatile("" ::: "memory");
#pragma unroll
            for (int m = 0; m < 4; ++m) { const int row = u.pm * 256 + ai * 128 + wr * 64 + fr * 4 + m; const size_t off = (size_t)row * DM + col0; float ss = 0.f;
#pragma unroll
                for (int bj = 0; bj < 2; ++bj) { const v4u r4 = rw[0][m][bj];
                    const f32x4 x0 = (f32x4){bflo(r4.x), bfhi(r4.x), bflo(r4.y), bfhi(r4.y)} + acc[ai][bj][m][0], x1 = (f32x4){bflo(r4.z), bfhi(r4.z), bflo(r4.w), bfhi(r4.w)} + acc[ai][bj][m][1];
                    if (fin) { *(f32x4*)(out + off + bj * 128) = x0; *(f32x4*)(out + off + bj * 128 + 4) = x1; }
                    else { ss += (x0[0] * x0[0] + x0[1] * x0[1]) + (x0[2] * x0[2] + x0[3] * x0[3]) + (x1[0] * x1[0] + x1[1] * x1[1]) + (x1[2] * x1[2] + x1[3] * x1[3]);
                        v4u w; w.x = pk2(x0[0], x0[1]); w.y = pk2(x0[2], x0[3]); w.z = pk2(x1[0], x1[1]); w.w = pk2(x1[2], x1[3]); *(v4u*)(XN + off + bj * 128) = w; } }
                if (!fin) { ss += __shfl_xor(ss, 16); ss += __shfl_xor(ss, 32); if (fq == 0) unsafeAtomicAdd(rss + row, ss); } }
        }
    }
};
DI float dpp_up1(float s) { return __builtin_bit_cast(float, __builtin_amdgcn_update_dpp(0, __builtin_bit_cast(int, s), 0x111, 0xf, 0xf, true)); }
struct EpiUp {
    static constexpr bool PERM = false, AFTER_DRAIN = false;
    unsigned char* ws; int l;
    DI void operator()(f32x4 (&acc)[2][2][4][2], const pg8::Unit& u, int wr, int wc, int fr, int fq) const {
        bf16* ACT = (bf16*)(ws + WS_ACT); float *BND = (float*)(ws + WS_BND), *HS = (float*)(ws + WS_HS);
        const float *cw = INP(19) + (size_t)l * 3 * NUP, *cb = INP(20) + (size_t)l * NUP; const float* rss = (const float*)(ws + WS_RSS);
        const int cbase = 128 * u.pn + 32 * wc + 8 * fq;
#pragma unroll
        for (int ai = 0; ai < 2; ++ai) { const f32x4 q = *(const f32x4*)(rss + u.pm * 256 + ai * 128 + wr * 64 + fr * 4);
#pragma unroll
            for (int m = 0; m < 4; ++m) { const float rs = frsq(q[m] * (1.0f / DM) + EPS);
#pragma unroll
                for (int bj = 0; bj < 2; ++bj)
#pragma unroll
                    for (int n = 0; n < 2; ++n) acc[ai][bj][m][n] *= rs; } }
        if (u.pm >= MP / 256) {
#pragma unroll
            for (int ai = 0; ai < 2; ++ai)
#pragma unroll
                for (int m = 0; m < 4; ++m) { float* hp = HS + (size_t)((u.pm - MP / 256) * 256 + ai * 128 + wr * 64 + fr * 4 + m) * NUP + cbase;
#pragma unroll
                    for (int bj = 0; bj < 2; ++bj)
#pragma unroll
                        for (int n = 0; n < 2; ++n) *(f32x4*)(hp + bj * DFF + 4 * n) = acc[ai][bj][m][n]; }
            return;
        }
        v2u keep[2][4];
#pragma unroll
        for (int n = 0; n < 2; ++n) {
            const int ca = cbase + 4 * n;
            const f32x4 w0a = *(const f32x4*)(cw + ca), w1a = *(const f32x4*)(cw + NUP + ca), w2a = *(const f32x4*)(cw + 2 * NUP + ca), ba = *(const f32x4*)(cb + ca);
            const f32x4 w0g = *(const f32x4*)(cw + DFF + ca), w1g = *(const f32x4*)(cw + NUP + DFF + ca), w2g = *(const f32x4*)(cw + 2 * NUP + DFF + ca), bg = *(const f32x4*)(cb + DFF + ca);
#pragma unroll
            for (int ai = 0; ai < 2; ++ai) {
                const int row0 = u.pm * 256 + ai * 128 + wr * 64 + fr * 4;
                const f32x4 a0 = acc[ai][0][0][n], a1 = acc[ai][0][1][n], a2 = acc[ai][0][2][n], a3 = acc[ai][0][3][n];
                const f32x4 g0 = acc[ai][1][0][n], g1 = acc[ai][1][1][n], g2 = acc[ai][1][2][n], g3 = acc[ai][1][3][n];
                f32x4 am1, am2, gm1, gm2;
#pragma unroll
                for (int e = 0; e < 4; ++e) { am1[e] = dpp_up1(a3[e]); am2[e] = dpp_up1(a2[e]); gm1[e] = dpp_up1(g3[e]); gm2[e] = dpp_up1(g2[e]); }
                f32x4 ha[4], hg[4];
                ha[0] = ba + w0a * am2 + w1a * am1 + w2a * a0; ha[1] = ba + w0a * am1 + w1a * a0 + w2a * a1; ha[2] = ba + w0a * a0 + w1a * a1 + w2a * a2; ha[3] = ba + w0a * a1 + w1a * a2 + w2a * a3;
                hg[0] = bg + w0g * gm2 + w1g * gm1 + w2g * g0; hg[1] = bg + w0g * gm1 + w1g * g0 + w2g * g1; hg[2] = bg + w0g * g0 + w1g * g1 + w2g * g2; hg[3] = bg + w0g * g1 + w1g * g2 + w2g * g3;
#pragma unroll
                for (int m = 0; m < 4; ++m) { v2u w; w.x = pk2(ha[m][0] * silu(hg[m][0]), ha[m][1] * silu(hg[m][1])); w.y = pk2(ha[m][2] * silu(hg[m][2]), ha[m][3] * silu(hg[m][3]));
                    if (n == 0) keep[ai][m] = w;
                    else { v4u w4; w4.x = keep[ai][m].x; w4.y = keep[ai][m].y; w4.z = w.x; w4.w = w.y; *(v4u*)(ACT + (size_t)(row0 + m) * DFF + cbase) = w4; } }
                if (fr == 0 || fr == 15) {
                    const bool lo = fr == 0; float* bp = BND + ((size_t)(row0 >> 6) * 4 + (lo ? 0 : 2)) * NUP + ca;
                    *(f32x4*)bp = lo ? a0 : a2; *(f32x4*)(bp + DFF) = lo ? g0 : g2; *(f32x4*)(bp + NUP) = lo ? a1 : a3; *(f32x4*)(bp + NUP + DFF) = lo ? g1 : g3; }
            }
        }
    }
};

template <int MAP> DI int slot_of(int c) {
    if (MAP == 1) { const int pn = c >> 8, t = c & 255, wc = t >> 6, i = t & 63, bj = i >> 5, r32 = i & 31, fq = r32 >> 3, n = (r32 >> 2) & 1, e = r32 & 3; return pn * 256 + bj * 128 + wc * 32 + n * 16 + fq * 4 + e; }
    if (MAP == 2) { const int part = c >= DFF ? 1 : 0, j = c - part * DFF, pn = j >> 7, i = j & 127, wc = i >> 5, r32 = i & 31, fq = r32 >> 3, n = (r32 >> 2) & 1, e = r32 & 3; return pn * 256 + part * 128 + wc * 32 + n * 16 + fq * 4 + e; }
    if (MAP == 3) { const int pn = c >> 8, t = c & 255, bj = t >> 7, wc = (t >> 5) & 3, r32 = t & 31, fq = r32 >> 3, n = (r32 >> 2) & 1, e = r32 & 3; return pn * 256 + bj * 128 + wc * 32 + n * 16 + fq * 4 + e; }
    return c;
}
template <int MAP> DI void transpose_item(const float* W, const float* gk  , int K, int N, bf16* WT, LAS unsigned* scr, int item, int lane) {
    const int nblk = N / 64, kb = item / nblk, nb = item % nblk, k0 = 64 * kb, n0 = 64 * nb;
    const int q = lane & 15, kp = lane >> 4;
#pragma unroll
    for (int i = 0; i < 8; ++i) { const int kpair = kp + 4 * i; const float* p = W + (size_t)(k0 + 2 * kpair) * N + n0 + 4 * q;
        const float g0 = gk ? gk[k0 + 2 * kpair] : 1.0f, g1 = gk ? gk[k0 + 2 * kpair + 1] : 1.0f;
        const f32x4 r0 = *(const f32x4*)p * g0, r1 = *(const f32x4*)(p + N) * g1;
#pragma unroll
        for (int j = 0; j < 4; ++j) scr[(4 * q + j) * 33 + kpair] = pk2(r0[j], r1[j]); }
    LDS_WAIT();
    const int c = lane & 7;
#pragma unroll
    for (int i = 0; i < 8; ++i) { const int n = (lane >> 3) + 8 * i; const LAS unsigned* s = scr + n * 33 + 4 * c; v4u o; o.x = s[0]; o.y = s[1]; o.z = s[2]; o.w = s[3];
        *(v4u*)(WT + (size_t)slot_of<MAP>(n0 + n) * K + k0 + 8 * c) = o; }
    LDS_WAIT();
}
DI void xg_row(const float* xrow, bf16* orow, float* rss, int lane) {
    f32x4 v[8]; float s = 0.f;
#pragma unroll
    for (int j = 0; j < 8; ++j) { v[j] = *((const f32x4*)xrow + lane + 64 * j); s += (v[j][0] * v[j][0] + v[j][1] * v[j][1]) + (v[j][2] * v[j][2] + v[j][3] * v[j][3]); }
    s = wave_sum(s); if (lane == 0) *rss = s;
#pragma unroll
    for (int j = 0; j < 8; ++j) { v2u w; w.x = pk2(v[j][0], v[j][1]); w.y = pk2(v[j][2], v[j][3]); *((v2u*)orow + lane + 64 * j) = w; }
}
DI void reduce_phase(Frame& F0, int rsel, bool fin) {
    Frame F = opaque(F0);
    unsigned char* ws = WSB(F); const float* P = (const float*)(ws + WS_PART); float* out = OUTB(F) + (size_t)MP * DM; bf16* XN = (bf16*)(ws + WS_XN) + (size_t)MP * DM; float* rss = (float*)(ws + WS_RSS) + rsel * MT + MP;
    for (int r = F.bid * 8 + F.wave; r < MS; r += F.G * 8) {
        f32x4 v[8]; float s = 0.f;
#pragma unroll
        for (int j = 0; j < 8; ++j) { const v2u w = *((const v2u*)(XN + (size_t)r * DM) + F.lane + 64 * j); v[j] = (f32x4){bflo(w.x), bfhi(w.x), bflo(w.y), bfhi(w.y)}; }
#pragma unroll 1
        for (int sp = 0; sp < NSPLIT; ++sp) {
#pragma unroll
            for (int j = 0; j < 8; ++j) v[j] += *((const f32x4*)(P + ((size_t)sp * MS + r) * DM) + F.lane + 64 * j); }
#pragma unroll
        for (int j = 0; j < 8; ++j) { s += (v[j][0] * v[j][0] + v[j][1] * v[j][1]) + (v[j][2] * v[j][2] + v[j][3] * v[j][3]);
            if (fin) *((f32x4*)(out + (size_t)r * DM) + F.lane + 64 * j) = v[j];
            else { v2u w; w.x = pk2(v[j][0], v[j][1]); w.y = pk2(v[j][2], v[j][3]); *((v2u*)(XN + (size_t)r * DM) + F.lane + 64 * j) = w; } }
        if (!fin) { s = wave_sum(s); if (F.lane == 0) rss[r] = s; }
    }
}
DI void zero_rss(Frame& F0, int rsel) {
    Frame F = opaque(F0); float* rss = (float*)(WSB(F) + WS_RSS) + rsel * MT;
    for (int i = F.bid * 512 + F.tid; i < MP; i += F.G * 512) rss[i] = 0.f;
}
DI void norm_phase(Frame& F0, const float* xp, const float* xs  ) {
    Frame F = opaque(F0);
    bf16* XN = (bf16*)(WSB(F) + WS_XN); float* rss = (float*)(WSB(F) + WS_RSS) + MT;
    for (int m = F.bid * 8 + F.wave; m < MT; m += F.G * 8) xg_row((m < MP ? xp : xs) + (size_t)m * DM, XN + (size_t)m * DM, rss + m, F.lane);
}
DI void convert_weights(Frame& F0, int l, int cu0, int i0, int i1) {
    Frame F = opaque(F0);
    if (F.bid < cu0) return;
    LAS unsigned* scr = (LAS unsigned*)(F.lds + F.wave * 16384);
    const int gw = (F.bid - cu0) * 8 + F.wave, NGW = (F.G - cu0) * 8;
    constexpr int I_IN = (DM / 64) * (NIN / 64), I_O = (DM / 64) * (DM / 64), I_UP = (DM / 64) * (NUP / 64), I_DN = (DFF / 64) * (DM / 64), I_L = I_IN + I_O + I_UP + I_DN;
    for (int it = i0 + gw; it < i1; it += NGW) {
        int r = it;
        if (r < I_IN) { transpose_item<1>(INP(6) + (size_t)l * DM * NIN, INP(5) + l * DM, DM, NIN, (bf16*)(WSB(F) + WS_WIN + l * 13 * MiB), scr, r, F.lane); continue; } r -= I_IN;
        if (r < I_O) { transpose_item<3>(INP(16) + (size_t)l * DM * DM, nullptr, DM, DM, (bf16*)(WSB(F) + WS_WO + l * 8 * MiB), scr, r, F.lane); continue; } r -= I_O;
        if (r < I_UP) { transpose_item<2>(INP(18) + (size_t)l * DM * NUP, INP(17) + l * DM, DM, NUP, (bf16*)(WSB(F) + WS_WUP + l * 43 * MiB), scr, r, F.lane); continue; } r -= I_UP;
        transpose_item<3>(INP(21) + (size_t)l * DFF * DM, nullptr, DFF, DM, (bf16*)(WSB(F) + WS_WDN + l * 22 * MiB), scr, r, F.lane);
    }
    __syncthreads();
}
constexpr int CV_IN = (DM / 64) * (NIN / 64), CV_O = CV_IN + (DM / 64) * (DM / 64), CV_UP = CV_O + (DM / 64) * (NUP / 64), CV_ALL = CV_UP + (DFF / 64) * (DM / 64);
DI void prologue(Frame& F0) {
    convert_weights(F0, 0, 0, 0, CV_O);
    norm_phase(F0, INP(0), INP(1) - (size_t)MP * DM);
}

DI void load_q(bf16x8 (&bq)[4], const bf16* qptr, int hh) {
#pragma unroll
    for (int ks = 0; ks < 4; ++ks) bq[ks] = *(const bf16x8*)(qptr + 16 * ks + 8 * hh);
}
DI float attn_qblock(LAS unsigned char* lds, int kv, int kb0, const bf16x8 (&bq)[4], int distbase, int kimin, float slope2, float sink2, bf16* optr, int lane) {
    const int r = lane & 31, hh = lane >> 5;
    f32x16 s[5];
#pragma unroll
    for (int t = 0; t < 5; ++t) {
#pragma unroll
        for (int i = 0; i < 16; ++i) s[t][i] = 0.f;
#pragma unroll
        for (int ks = 0; ks < 4; ++ks) { const bf16x8 kf = *(const LAS bf16x8*)(lds + KS_OFF + (kv * 192 + 32 * (kb0 + t) + r) * KS_STRIDE + (16 * ks + 8 * hh) * 2); s[t] = MFMA32(kf, bq[ks], s[t]); }
        if (t & 1) __builtin_amdgcn_sched_barrier(0);
    }
    __builtin_amdgcn_sched_barrier(0);
    float mx = sink2;
    int kloi = max(kimin, distbase - 127) - 32 * kb0 - 4 * hh, khii = distbase - 32 * kb0 - 4 * hh;
    asm volatile("" : "+v"(kloi), "+v"(khii));
    const float klof = (float)kloi, khif = (float)khii, base = -slope2 * khif;
#pragma unroll
    for (int t = 0; t < 5; ++t)
#pragma unroll
        for (int i = 0; i < 16; ++i) { const float kkf = (float)(32 * t + crow(i, 0));
            const float x = __builtin_fmaf(slope2, kkf, __builtin_fmaf(s[t][i], 0.125f * LOG2E, base));
            const int msk = __float_as_int(fminf(kkf - klof, khif - kkf)) >> 31;
            const float v = __int_as_float((__float_as_int(x) & ~msk) | (__float_as_int(-1e30f) & msk)); s[t][i] = v; mx = fmaxf(mx, v); }
    mx = fmaxf(mx, __shfl_xor(mx, 32));
    float l = 0.f;
#pragma unroll
    for (int t = 0; t < 5; ++t)
#pragma unroll
        for (int i = 0; i < 16; ++i) { const float p = fexp2(s[t][i] - mx); s[t][i] = p; l += p; }
    l += __shfl_xor(l, 32); l += fexp2(sink2 - mx);
    __builtin_amdgcn_sched_barrier(0);
    f32x16 o[2];
#pragma unroll
    for (int db = 0; db < 2; ++db)
#pragma unroll
        for (int i = 0; i < 16; ++i) o[db][i] = 0.f;
#pragma unroll
    for (int t = 0; t < 5; ++t)
#pragma unroll
        for (int st = 0; st < 2; ++st) {
            v4u pw; pw.x = pk2(s[t][8 * st], s[t][8 * st + 1]); pw.y = pk2(s[t][8 * st + 2], s[t][8 * st + 3]); pw.z = pk2(s[t][8 * st + 4], s[t][8 * st + 5]); pw.w = pk2(s[t][8 * st + 6], s[t][8 * st + 7]);
            const bf16x8 pf = __builtin_bit_cast(bf16x8, pw);
#pragma unroll
            for (int db = 0; db < 2; ++db) { const LAS unsigned char* a = lds + VT_OFF + (kv * 64 + 32 * db + r) * VT_STRIDE + (32 * (kb0 + t) + 16 * st + 4 * hh) * 2;
                const s16x4 lo = *(const LAS s16x4*)a, hi = *(const LAS s16x4*)(a + 16); const bf16x8 vf = __builtin_shufflevector(lo, hi, 0, 1, 2, 3, 4, 5, 6, 7);
                o[db] = MFMA32(vf, pf, o[db]); }
        }
    const float inv = frcp(l); float ssq = 0.f;
#pragma unroll
    for (int db = 0; db < 2; ++db)
#pragma unroll
        for (int g = 0; g < 4; ++g) { const float a0 = o[db][4 * g] * inv, a1 = o[db][4 * g + 1] * inv, a2 = o[db][4 * g + 2] * inv, a3 = o[db][4 * g + 3] * inv;
            ssq += (a0 * a0 + a1 * a1) + (a2 * a2 + a3 * a3); v2u w; w.x = pk2(a0, a1); w.y = pk2(a2, a3); *(v2u*)(optr + 32 * db + 8 * g + 4 * hh) = w; }
    return ssq;
}
DI void put_k(LAS unsigned char* lds, int kv, int ki, int d0, v4u w) { *(LAS v4u*)(lds + KS_OFF + (kv * 192 + ki) * KS_STRIDE + d0 * 2) = w; }
DI void put_v(LAS unsigned char* lds, int kv, int ki, int d0, v4u w) {
    LAS unsigned short* p = (LAS unsigned short*)(lds + VT_OFF + (kv * 64 + d0) * VT_STRIDE + ki * 2);
    p[0 * (VT_STRIDE / 2)] = (unsigned short)(w.x & 0xffff); p[1 * (VT_STRIDE / 2)] = (unsigned short)(w.x >> 16); p[2 * (VT_STRIDE / 2)] = (unsigned short)(w.y & 0xffff); p[3 * (VT_STRIDE / 2)] = (unsigned short)(w.y >> 16);
    p[4 * (VT_STRIDE / 2)] = (unsigned short)(w.z & 0xffff); p[5 * (VT_STRIDE / 2)] = (unsigned short)(w.z >> 16); p[6 * (VT_STRIDE / 2)] = (unsigned short)(w.w & 0xffff); p[7 * (VT_STRIDE / 2)] = (unsigned short)(w.w >> 16);
}
DI void rescale_rows(Frame& F, bf16* MG, int m0, int nrows, const float* goa, const float* gos) {
    LAS float* ST = (LAS float*)(F.lds + ST_OFF);
#pragma unroll 4
    for (int c = F.tid; c < nrows * 256; c += 512) { const int row = c >> 8, cc = (c & 255) * 8; bf16* p = MG + (size_t)(m0 + row) * DM + cc; const v4u raw = *(const v4u*)p;
        const float sc = cc < 1024 ? ST[1280 + row] : ST[1344 + row]; const float* gp = cc < 1024 ? goa + cc : gos + (cc - 1024); const f32x4 g0 = *(const f32x4*)gp, g1 = *(const f32x4*)(gp + 4);
        v4u w; w.x = pk2(bflo(raw.x) * sc * g0[0], bfhi(raw.x) * sc * g0[1]); w.y = pk2(bflo(raw.y) * sc * g0[2], bfhi(raw.y) * sc * g0[3]);
        w.z = pk2(bflo(raw.z) * sc * g1[0], bfhi(raw.z) * sc * g1[1]); w.w = pk2(bflo(raw.w) * sc * g1[2], bfhi(raw.w) * sc * g1[3]); *(v4u*)p = w; }
}
DI void mixer_prompt_item(Frame& F0, int l, int item) {
    Frame F = opaque(F0);
    const bf16 *Q = (const bf16*)(WSB(F) + WS_Q), *Kb = (const bf16*)(WSB(F) + WS_K), *Vb = (const bf16*)(WSB(F) + WS_V), *U = (const bf16*)(WSB(F) + WS_U), *VS = (const bf16*)(WSB(F) + WS_VS);
    bf16* MG = (bf16*)(WSB(F) + WS_MG);
    LAS float* ST = (LAS float*)(F.lds + ST_OFF);
    const int b = item >> 5, t0 = (item & 31) * 64, m0 = b * SEQ + t0, tq = t0 & 64, mc = m0 - tq, S = tq + 64;
    const int lane = F.lane, w = F.wave, r = lane & 31, hh = lane >> 5;
    for (int c = F.tid; c < 192 * 16; c += 512) { const int ki = c >> 4, ch = c & 15, kv = ch >> 3, d0 = (ch & 7) * 8; int pos = t0 - 128 + ki; pos = pos < 0 ? 0 : pos;
        const size_t off = (size_t)(b * SEQ + pos) * 128 + kv * 64 + d0; put_k(F.lds, kv, ki, d0, *(const v4u*)(Kb + off)); put_v(F.lds, kv, ki, d0, *(const v4u*)(Vb + off)); }
    __syncthreads();
    for (int rp_ = 0; rp_ < ((MK_MIXDUP & 1) ? 2 : 1); ++rp_)
    {
        const int kv = w >> 2; float sq0 = 0.f, sq1 = 0.f;
        bf16x8 bq[4], bqn[4];
        load_q(bq, Q + (size_t)(m0 + r) * 1024 + (2 * w) * 64, hh);
        const float* sinks = INP(9) + l * 16;
#pragma unroll 1
        for (int it = 0; it < 4; ++it) { const int hs = it >> 1, qb = it & 1; const int h = 2 * w + hs; const float slope2 = fexp2(-0.5f * (float)(h + 1)) * LOG2E, sink2 = sinks[h] * LOG2E;
            const int row = m0 + 32 * qb + r;
            load_q(bq, Q + (size_t)row * 1024 + h * 64, hh);
            float s = attn_qblock(F.lds, kv, qb, bq, 32 * qb + r + 128, 128 - t0, slope2, sink2, MG + (size_t)row * DM + h * 64, lane);
            s += __shfl_xor(s, 32); sq0 += qb == 0 ? s : 0.f; sq1 += qb == 1 ? s : 0.f;
}
        if (hh == 0) { ST[w * 64 + r] = sq0; ST[w * 64 + 32 + r] = sq1; }
    }
    __syncthreads();
#pragma unroll 1
    for (int rq_ = 0; rq_ < ((MK_MIXDUP & 2) ? 2 : 1); ++rq_) {
    for (int sb = w; sb < S; sb += 32) {
        v4u a[4], c[4];
#pragma unroll
        for (int k = 0; k < 4; ++k) { const bf16* p = VS + (size_t)(mc + sb + 8 * k) * 1024 + 8 * lane; a[k] = *(const v4u*)p; c[k] = *(const v4u*)(p + 512); }
#pragma unroll
        for (int k = 0; k < 4; ++k) {
            const float x[16] = {bflo(a[k].x), bfhi(a[k].x), bflo(a[k].y), bfhi(a[k].y), bflo(a[k].z), bfhi(a[k].z), bflo(a[k].w), bfhi(a[k].w), bflo(c[k].x), bfhi(c[k].x), bflo(c[k].y), bfhi(c[k].y), bflo(c[k].z), bfhi(c[k].z), bflo(c[k].w), bfhi(c[k].w)};
            float sm = 0.f, s2 = 0.f;
#pragma unroll
            for (int j = 0; j < 16; ++j) { sm += x[j]; s2 += x[j] * x[j]; }
            sm = wave_sum(sm); s2 = wave_sum(s2); const float mu = sm * (1.0f / 1024.0f), var = s2 * (1.0f / 1024.0f) - mu * mu;
            if (lane == 0) { ST[1024 + sb + 8 * k] = mu; ST[1152 + sb + 8 * k] = frsq(fmaxf(var, 0.f) + EPS); } } }
    __syncthreads();
    {
        const int h = w; LAS unsigned char* vst = F.lds + w * SG_WAVE;
        const float* lng = INP(10) + l * 1024 + h * 128; const float* lnb = INP(11) + l * 1024 + h * 128;
        const float* Wl = INP(12) + (size_t)(l * 8 + h) * 128 * 128; const float* bsl = INP(13) + (l * 8 + h) * 128;
        float sq0 = 0.f, sq1 = 0.f;
        bf16x8 wf[2][8];
#pragma unroll
        for (int tb = 0; tb < 2; ++tb) { const int t = tq + 32 * tb + r, nks = (tq + 32 * tb + 32) >> 4;
#pragma unroll
            for (int ks = 0; ks < 8; ++ks) { v4u bw = (v4u){0u, 0u, 0u, 0u};
                if (ks < nks) { const int s0 = 16 * ks + 8 * hh; const float* wp = Wl + (size_t)t * 128 + s0; const f32x4 w0 = *(const f32x4*)wp, w1 = *(const f32x4*)(wp + 4);
                    bw.x = pk2(s0 <= t ? w0[0] : 0.f, s0 + 1 <= t ? w0[1] : 0.f); bw.y = pk2(s0 + 2 <= t ? w0[2] : 0.f, s0 + 3 <= t ? w0[3] : 0.f);
                    bw.z = pk2(s0 + 4 <= t ? w1[0] : 0.f, s0 + 5 <= t ? w1[1] : 0.f); bw.w = pk2(s0 + 6 <= t ? w1[2] : 0.f, s0 + 7 <= t ? w1[3] : 0.f); }
                wf[tb][ks] = __builtin_bit_cast(bf16x8, bw); } }
        const int nch = S * 4;
#pragma unroll 1
        for (int eq = 0; eq < 4; ++eq) {
            { const int e0 = (lane & 3) * 8; const f32x4 g0 = *(const f32x4*)(lng + 32 * eq + e0), g1 = *(const f32x4*)(lng + 32 * eq + e0 + 4), b0 = *(const f32x4*)(lnb + 32 * eq + e0), b1 = *(const f32x4*)(lnb + 32 * eq + e0 + 4);
#pragma unroll 1
            for (int ib = 0; ib < nch; ib += 256) {
                v4u raw[4];
#pragma unroll
                for (int i = 0; i < 4; ++i) { const int c = ib + lane + 64 * i; raw[i] = *(const v4u*)(VS + (size_t)(mc + (c >> 2)) * 1024 + h * 128 + 32 * eq + (c & 3) * 8); }
#pragma unroll
                for (int i = 0; i < 4; ++i) { const int c = ib + lane + 64 * i; const int s = c >> 2; const float mu = ST[1024 + s], rs = ST[1152 + s]; const v4u rw = raw[i];
                    const unsigned y01 = pk2((bflo(rw.x) - mu) * rs * g0[0] + b0[0], (bfhi(rw.x) - mu) * rs * g0[1] + b0[1]), y23 = pk2((bflo(rw.y) - mu) * rs * g0[2] + b0[2], (bfhi(rw.y) - mu) * rs * g0[3] + b0[3]);
                    const unsigned y45 = pk2((bflo(rw.z) - mu) * rs * g1[0] + b1[0], (bfhi(rw.z) - mu) * rs * g1[1] + b1[1]), y67 = pk2((bflo(rw.w) - mu) * rs * g1[2] + b1[2], (bfhi(rw.w) - mu) * rs * g1[3] + b1[3]);
                    LAS unsigned short* p = (LAS unsigned short*)(vst + e0 * 272 + s * 2);
                    p[0] = (unsigned short)(y01 & 0xffff); p[136] = (unsigned short)(y01 >> 16); p[272] = (unsigned short)(y23 & 0xffff); p[408] = (unsigned short)(y23 >> 16);
                    p[544] = (unsigned short)(y45 & 0xffff); p[680] = (unsigned short)(y45 >> 16); p[816] = (unsigned short)(y67 & 0xffff); p[952] = (unsigned short)(y67 >> 16); } } }
            LDS_WAIT();
#pragma unroll
            for (int tb = 0; tb < 2; ++tb) {
                const int t = tq + 32 * tb + r, nks = (tq + 32 * tb + 32) >> 4;
                const float bs = bsl[t]; const size_t row = (size_t)(mc + t);
                v2u ur[4];
#pragma unroll
                for (int g = 0; g < 4; ++g) ur[g] = *(const v2u*)(U + row * 1024 + h * 128 + 32 * eq + 8 * g + 4 * hh);
                f32x16 acc;
#pragma unroll
                for (int i = 0; i < 16; ++i) acc[i] = 0.f;
#pragma unroll
                for (int ks = 0; ks < 8; ++ks) if (ks < nks) { const bf16x8 af = *(const LAS bf16x8*)(vst + r * 272 + (16 * ks + 8 * hh) * 2); acc = MFMA32(af, wf[tb][ks], acc); }
                float ss = 0.f;
#pragma unroll
                for (int g = 0; g < 4; ++g) { const int e = 32 * eq + 8 * g + 4 * hh;
                    const float a0 = (acc[4 * g] + bs) * bflo(ur[g].x), a1 = (acc[4 * g + 1] + bs) * bfhi(ur[g].x), a2 = (acc[4 * g + 2] + bs) * bflo(ur[g].y), a3 = (acc[4 * g + 3] + bs) * bfhi(ur[g].y);
                    ss += (a0 * a0 + a1 * a1) + (a2 * a2 + a3 * a3); v2u o; o.x = pk2(a0, a1); o.y = pk2(a2, a3); *(v2u*)(MG + row * DM + 1024 + h * 128 + e) = o; }
                ss += __shfl_xor(ss, 32); if (tb == 0) sq0 += ss; else sq1 += ss;
            }
            LDS_WAIT();
        }
        if (hh == 0) { ST[512 + w * 64 + r] = sq0; ST[512 + w * 64 + 32 + r] = sq1; }
    }
    __syncthreads();
    }
    if (F.tid < 64) { float a = 0.f, s = 0.f;
#pragma unroll
        for (int k = 0; k < 8; ++k) { a += ST[k * 64 + F.tid]; s += ST[512 + k * 64 + F.tid]; }
        ST[1280 + F.tid] = frsq(a * (1.0f / 1024.0f) + EPS); ST[1344 + F.tid] = frsq(s * (1.0f / 1024.0f) + EPS); }
    __syncthreads();
    rescale_rows(F, MG, m0, 64, INP(14) + l * 1024, INP(15) + l * 1024);
    __syncthreads();
}
DI void mixer_sample_item(Frame& F0, int l, int seq) {
    Frame F = opaque(F0);
    const bf16 *Q = (const bf16*)(WSB(F) + WS_Q), *Kb = (const bf16*)(WSB(F) + WS_K), *Vb = (const bf16*)(WSB(F) + WS_V), *U = (const bf16*)(WSB(F) + WS_U), *VS = (const bf16*)(WSB(F) + WS_VS);
    bf16* MG = (bf16*)(WSB(F) + WS_MG);
    LAS float* ST = (LAS float*)(F.lds + ST_OFF);
    const int lane = F.lane, w = F.wave, m0 = MP + seq * 4;
    const float* ck = INP(2) + (size_t)(l * 128 + seq) * 128 * 128; const float* cv = INP(3) + (size_t)(l * 128 + seq) * 128 * 128;
    float* okw = OUTB(F) + O_KS + (size_t)(l * 128 + seq) * 128 * 128; float* ovw = OUTB(F) + O_VSO + (size_t)(l * 128 + seq) * 128 * 128;
    if (F.tid < 8) ST[F.tid] = 0.f;
    for (int c = F.tid; c < 160 * 16; c += 512) { const int ki = c >> 4, ch = c & 15, kv = ch >> 3, d0 = (ch & 7) * 8; v4u kw, vw;
        if (ki < 128) { const float* kp = ck + (size_t)ki * 128 + kv * 64 + d0; const float* vp = cv + (size_t)ki * 128 + kv * 64 + d0;
            const f32x4 k0 = *(const f32x4*)kp, k1 = *(const f32x4*)(kp + 4), v0 = *(const f32x4*)vp, v1 = *(const f32x4*)(vp + 4);
            if (ki >= 4) { float* ok = okw + (size_t)(ki - 4) * 128 + kv * 64 + d0; float* ov = ovw + (size_t)(ki - 4) * 128 + kv * 64 + d0; *(f32x4*)ok = k0; *(f32x4*)(ok + 4) = k1; *(f32x4*)ov = v0; *(f32x4*)(ov + 4) = v1; }
            kw.x = pk2(k0[0], k0[1]); kw.y = pk2(k0[2], k0[3]); kw.z = pk2(k1[0], k1[1]); kw.w = pk2(k1[2], k1[3]); vw.x = pk2(v0[0], v0[1]); vw.y = pk2(v0[2], v0[3]); vw.z = pk2(v1[0], v1[1]); vw.w = pk2(v1[2], v1[3]);
        } else if (ki < 132) { const size_t off = (size_t)(m0 + ki - 128) * 128 + kv * 64 + d0; kw = *(const v4u*)(Kb + off); vw = *(const v4u*)(Vb + off); }
        else { kw = (v4u){0u, 0u, 0u, 0u}; vw = kw; }
        put_k(F.lds, kv, ki, d0, kw); put_v(F.lds, kv, ki, d0, vw); }
    __syncthreads();
    if (w < 2) { const int kv = w, j = lane & 31, t = j >> 3, h = kv * 8 + (j & 7), row = m0 + t; const float slope2 = fexp2(-0.5f * (float)(h + 1)) * LOG2E, sink2 = INP(9)[l * 16 + h] * LOG2E;
        bf16x8 bq[4]; load_q(bq, Q + (size_t)row * 1024 + h * 64, lane >> 5);
        float s = attn_qblock(F.lds, kv, 0, bq, 128 + t, 0, slope2, sink2, MG + (size_t)row * DM + h * 64, lane);
        atomicAdd((float*)(ST + t), s); }
    __syncthreads();
    LAS float* VN = (LAS float*)F.lds;
    if (w < 4) { const bf16* p = VS + (size_t)(m0 + w) * 1024 + 8 * lane; const v4u a = *(const v4u*)p, c = *(const v4u*)(p + 512);
        float x[16] = {bflo(a.x), bfhi(a.x), bflo(a.y), bfhi(a.y), bflo(a.z), bfhi(a.z), bflo(a.w), bfhi(a.w), bflo(c.x), bfhi(c.x), bflo(c.y), bfhi(c.y), bflo(c.z), bfhi(c.z), bflo(c.w), bfhi(c.w)};
        float sm = 0.f, s2 = 0.f;
#pragma unroll
        for (int j = 0; j < 16; ++j) { sm += x[j]; s2 += x[j] * x[j]; }
        sm = wave_sum(sm); s2 = wave_sum(s2); const float mu = sm * (1.0f / 1024.0f), rs = frsq(fmaxf(s2 * (1.0f / 1024.0f) - mu * mu, 0.f) + EPS);
        const float* lng = INP(10) + l * 1024; const float* lnb = INP(11) + l * 1024; float* osv = OUTB(F) + O_SV + (size_t)((l * 128 + seq) * 4 + w) * 1024;
#pragma unroll
        for (int hf = 0; hf < 2; ++hf) { const int c0 = 512 * hf + 8 * lane;
#pragma unroll
            for (int q4 = 0; q4 < 2; ++q4) { const f32x4 g = *(const f32x4*)(lng + c0 + 4 * q4), bb = *(const f32x4*)(lnb + c0 + 4 * q4); f32x4 y;
#pragma unroll
                for (int e = 0; e < 4; ++e) y[e] = (x[8 * hf + 4 * q4 + e] - mu) * rs * g[e] + bb[e];
                *(f32x4*)(osv + c0 + 4 * q4) = y; *(LAS f32x4*)(VN + w * 1024 + c0 + 4 * q4) = y; } } }
    __syncthreads();
    { const int t = F.tid >> 7, c0 = (F.tid & 127) * 8, h = c0 >> 7; const float* Wr = INP(12) + ((size_t)(l * 8 + h) * 128 + t) * 128; const float bs = INP(13)[(l * 8 + h) * 128 + t];
        const v4u ur = *(const v4u*)(U + (size_t)(m0 + t) * 1024 + c0); const float uu[8] = {bflo(ur.x), bfhi(ur.x), bflo(ur.y), bfhi(ur.y), bflo(ur.z), bfhi(ur.z), bflo(ur.w), bfhi(ur.w)};
        float o[8]; float ss = 0.f;
#pragma unroll
        for (int j = 0; j < 8; ++j) { float mix = bs;
#pragma unroll
            for (int s = 0; s < 4; ++s) mix += (s <= t ? Wr[s] : 0.f) * VN[s * 1024 + c0 + j];
            o[j] = uu[j] * mix; ss += o[j] * o[j]; }
        v4u wv; wv.x = pk2(o[0], o[1]); wv.y = pk2(o[2], o[3]); wv.z = pk2(o[4], o[5]); wv.w = pk2(o[6], o[7]); *(v4u*)(MG + (size_t)(m0 + t) * DM + 1024 + c0) = wv;
        ss = wave_sum(ss); if (lane == 0) atomicAdd((float*)(ST + 4 + t), ss); }
    __syncthreads();
    if (F.tid < 4) { ST[1280 + F.tid] = frsq(ST[F.tid] * (1.0f / 1024.0f) + EPS); ST[1344 + F.tid] = frsq(ST[4 + F.tid] * (1.0f / 1024.0f) + EPS); }
    __syncthreads();
    rescale_rows(F, MG, m0, 4, INP(14) + l * 1024, INP(15) + l * 1024);
    __syncthreads();
}
DI void mixer_phase(Frame& F0, int l) {
    Frame F = opaque(F0);
    if (l == 0) convert_weights(F0, 0, (256 + 128) % F.G, CV_UP, CV_ALL);
    for (int it = F.bid; it < 256 + 128; it += F.G) { if (it < 256) { if (PHEN(8)) mixer_prompt_item(F, l, it); } else { if (PHEN(9)) mixer_sample_item(F, l, it - 256); } }
}
DI void fix_phase(Frame& F0, int l) {
    Frame F = opaque(F0);
    bf16* ACT = (bf16*)(WSB(F) + WS_ACT); const float* BND = (const float*)(WSB(F) + WS_BND); const float* HS = (const float*)(WSB(F) + WS_HS);
    const float* cw = INP(19) + (size_t)l * 3 * NUP; const float* cb = INP(20) + (size_t)l * NUP; const float* stin = INP(4) + (size_t)l * 128 * 2 * NUP; float* outb = OUTB(F);
    const int gt = F.bid * 512 + F.tid, NT = F.G * 512;
    constexpr int CQ = DFF / 4;
    constexpr int NA = CQ * 64, NC = CQ * 32;
    for (int i = gt; i < NA + NC; i += NT) {
        const bool smp = i >= NA; const int j = smp ? i - NA : i, cq = j % CQ, grp = j / CQ, c = cq * 4;
        f32x4 w0[2], w1[2], w2[2], bb[2];
#pragma unroll
        for (int part = 0; part < 2; ++part) { const int cc = part * DFF + c; w0[part] = *(const f32x4*)(cw + cc); w1[part] = *(const f32x4*)(cw + NUP + cc); w2[part] = *(const f32x4*)(cw + 2 * NUP + cc); bb[part] = *(const f32x4*)(cb + cc); }
        if (!smp) {
#pragma unroll 2
            for (int k = 0; k < 4; ++k) { const int blk = grp * 4 + k; const bool first = (blk & 31) == 0; f32x4 act0, act1;
#pragma unroll
                for (int part = 0; part < 2; ++part) { const int cc = part * DFF + c; const f32x4 z = (f32x4){0.f, 0.f, 0.f, 0.f};
                    const float* cur = BND + (size_t)blk * 4 * NUP + cc; const float* prv = cur - (size_t)4 * NUP;
                    const f32x4 h0 = *(const f32x4*)cur, h1 = *(const f32x4*)(cur + NUP), hm2 = first ? z : *(const f32x4*)(prv + 2 * NUP), hm1 = first ? z : *(const f32x4*)(prv + 3 * NUP);
                    const f32x4 r0 = bb[part] + w0[part] * hm2 + w1[part] * hm1 + w2[part] * h0, r1 = bb[part] + w0[part] * hm1 + w1[part] * h0 + w2[part] * h1;
                    if (part == 0) { act0 = r0; act1 = r1; } else {
#pragma unroll
                        for (int e = 0; e < 4; ++e) { act0[e] *= silu(r0[e]); act1[e] *= silu(r1[e]); } } }
                v2u w; w.x = pk2(act0[0], act0[1]); w.y = pk2(act0[2], act0[3]); *(v2u*)(ACT + (size_t)(blk * 64) * DFF + c) = w;
                w.x = pk2(act1[0], act1[1]); w.y = pk2(act1[2], act1[3]); *(v2u*)(ACT + (size_t)(blk * 64 + 1) * DFF + c) = w; }
        } else {
#pragma unroll 1
            for (int k = 0; k < 4; ++k) { const int seq = grp * 4 + k; f32x4 act[4];
#pragma unroll
                for (int part = 0; part < 2; ++part) { const int cc = part * DFF + c; const float* st = stin + (size_t)seq * 2 * NUP + cc; const float* hs = HS + (size_t)seq * 4 * NUP + cc;
                    f32x4 hp[6]; hp[0] = *(const f32x4*)st; hp[1] = *(const f32x4*)(st + NUP);
#pragma unroll
                    for (int t = 0; t < 4; ++t) hp[2 + t] = *(const f32x4*)(hs + (size_t)t * NUP);
                    float* oc = outb + O_CS + (size_t)(l * 128 + seq) * 2 * NUP + cc; *(f32x4*)oc = hp[4]; *(f32x4*)(oc + NUP) = hp[5];
#pragma unroll
                    for (int t = 0; t < 4; ++t) { const f32x4 hc = bb[part] + w0[part] * hp[t] + w1[part] * hp[t + 1] + w2[part] * hp[t + 2];
                        if (part == 0) act[t] = hc; else {
#pragma unroll
                            for (int e = 0; e < 4; ++e) act[t][e] *= silu(hc[e]); } } }
#pragma unroll
                for (int t = 0; t < 4; ++t) { v2u w; w.x = pk2(act[t][0], act[t][1]); w.y = pk2(act[t][2], act[t][3]); *(v2u*)(ACT + (size_t)(MP + seq * 4 + t) * DFF + c) = w; } }
        }
    }
    for (int i = gt; i < 8 * 2 * (NUP / 4); i += NT) { const int cq = i % (NUP / 4), rr = (i / (NUP / 4)) & 1, b = i / (2 * (NUP / 4));
        *(f32x4*)(outb + O_CP + ((size_t)(l * 8 + b) * 2 + rr) * NUP + cq * 4) = *(const f32x4*)(BND + ((size_t)(b * 32 + 31) * 4 + 2 + rr) * NUP + cq * 4); }
}

#define XB_TMO      128
#define XB_XCNT(j)  (256  + 64 * (j))
#define XB_XSUB(j)  (1280 + 64 * (j))
#define XB_XGEN(j)  (2304 + 64 * (j))
#define XB_TOP      3328
#define XB_TOPGEN   3392
#define XCD_BAR_WORDS 3456
#define XB_SPIN_CAP (1u << 18)

__device__ __forceinline__ unsigned xb_ld(unsigned* p)              { return __hip_atomic_load(p, __ATOMIC_RELAXED, __HIP_MEMORY_SCOPE_AGENT); }
__device__ __forceinline__ unsigned xb_add(unsigned* p, unsigned v) { return __hip_atomic_fetch_add(p, v, __ATOMIC_RELAXED, __HIP_MEMORY_SCOPE_AGENT); }
__device__ __forceinline__ unsigned xb_xcc_id() { return (unsigned)__builtin_amdgcn_s_getreg((3 << 11) | 20) & 0xFu; }
#define XB_SPIN(cond, bar) do { unsigned _sp = 0; while (cond) { __builtin_amdgcn_s_sleep(1); \
    if ((++_sp & 255u) == 0u) { if (xb_ld(&(bar)[XB_TMO])) break; if (_sp > XB_SPIN_CAP) { atomicAdd(&(bar)[XB_TMO], 1u); break; } } } } while (0)

struct XcdBarrier {
    unsigned* bar; unsigned x;
    volatile LAS unsigned* st;
};

__device__ __forceinline__ XcdBarrier xcd_barrier_post(unsigned* bar, volatile LAS unsigned* st) {
    XcdBarrier b; b.bar = bar; b.x = xb_xcc_id(); b.st = st;
    if (threadIdx.x == 0) (void)xb_add(&bar[XB_XCNT(b.x)], 1u);
    return b;
}
__device__ __forceinline__ void xcd_barrier_complete(unsigned* bar, unsigned x, unsigned& nloc, unsigned& nx) {
    const unsigned G = gridDim.x * gridDim.y * gridDim.z;
    unsigned sum, cnt, mine, sp = 0u;
    for (;;) {
        sum = 0u; cnt = 0u; mine = 0u;
#pragma unroll
        for (unsigned j = 0; j < 16; ++j) { const unsigned c = xb_ld(&bar[XB_XCNT(j)]); sum += c; cnt += (c > 0u) ? 1u : 0u; mine = (j == x) ? c : mine; }
        if (sum == G) break;
        __builtin_amdgcn_s_sleep(1);
        if ((++sp & 255u) == 0u) { if (xb_ld(&bar[XB_TMO])) break; if (sp > XB_SPIN_CAP) { atomicAdd(&bar[XB_TMO], 1u); break; } }
    }
    nloc = mine > 0u ? mine : 1u; nx = cnt > 0u ? cnt : 1u;
}

__device__ __forceinline__ void xcd_barrier(const XcdBarrier& b) {
    asm volatile("s_waitcnt vmcnt(0)" ::: "memory");
    __syncthreads();
    if (threadIdx.x == 0) {
        unsigned* bar = b.bar;
        __builtin_amdgcn_s_waitcnt(0);
        unsigned nloc = b.st[0], nx = b.st[1];
        if (nloc == 0u) { xcd_barrier_complete(bar, b.x, nloc, nx); b.st[0] = nloc; b.st[1] = nx; }
        const unsigned old = xb_add(&bar[XB_XSUB(b.x)], 1u);
        const unsigned gen = old / nloc;
        if (old + 1u == (gen + 1u) * nloc) {
            __builtin_amdgcn_fence(__ATOMIC_RELEASE, "agent");
            asm volatile("s_waitcnt vmcnt(0)" ::: "memory");
            const unsigned og = xb_add(&bar[XB_TOP], 1u);
            const unsigned tg = og / nx;
            if (og + 1u == (tg + 1u) * nx) xb_add(&bar[XB_TOPGEN], 1u);
            else XB_SPIN(xb_ld(&bar[XB_TOPGEN]) == tg, bar);
            __builtin_amdgcn_fence(__ATOMIC_ACQUIRE, "agent");
            xb_add(&bar[XB_XGEN(b.x)], 1u);
            asm volatile("s_waitcnt vmcnt(0)" ::: "memory");
        } else {
            XB_SPIN(xb_ld(&bar[XB_XGEN(b.x)]) == gen, bar);
            __builtin_amdgcn_fence(__ATOMIC_ACQUIRE, "agent");
            asm volatile("s_waitcnt vmcnt(0)" ::: "memory");
        }
    }
    __syncthreads();
}

__global__ void __launch_bounds__(512, 2) mk_fwd(Args args) {
    extern __shared__ __attribute__((aligned(16))) unsigned char lds[];
    Frame F;
    F.lds = (LAS unsigned char*)lds; F.tid = 0; F.lane = 0; F.wave = __builtin_amdgcn_readfirstlane((int)threadIdx.x >> 6); F.G = gridDim.x; F.bid = blockIdx.x;
    F.out = args.out; F.ws = args.ws;
    const int lo = args.ph_lo, hi = args.ph_hi;
    volatile LAS unsigned* bst = (volatile LAS unsigned*)(F.lds + LDS_BYTES - 64);
    if (threadIdx.x < 16) bst[threadIdx.x] = 0u;
    __syncthreads();
    (void)xcd_barrier_post((unsigned*)(args.ws) + CW_BAR, bst);
#define IN(k) (lo <= (k) && (k) < hi)
#define SEAMX() do { XcdBarrier b_; b_.bar = (unsigned*)WSB(F) + CW_BAR; b_.x = xb_xcc_id(); b_.st = (volatile LAS unsigned*)(F.lds + LDS_BYTES - 64); xcd_barrier(b_); } while (0)
#define SEAM(k) do { if (IN(k) && IN((k) + 1)) { if ((k) == 0) cg::this_grid().sync(); else { XcdBarrier b_; b_.bar = (unsigned*)WSB(F) + CW_BAR; b_.x = xb_xcc_id(); b_.st = (volatile LAS unsigned*)(F.lds + LDS_BYTES - 64); xcd_barrier(b_); } } } while (0)
    if (PHEN(0) && IN(0)) { prologue(F); } SEAM(0);
#ifdef MK_XSYNC
#pragma unroll 1
    for (int xs_ = 0; xs_ < MK_XSYNC; ++xs_) cg::this_grid().sync();
#endif
#pragma unroll 1
    for (int l = 0; l < DEPTH; ++l) {
        const int p0 = 1 + 8 * l;
        if (PHEN(1) && IN(p0)) {
            zero_rss(F, 0);
            pg8::Gemm g{(const bf16*)(WSB(F) + WS_XN), (const bf16*)(WSB(F) + WS_WIN + l * 13 * MiB), MT, NIN, DM, F.wave}; pg8::StaticOrder S; S.init(MT, NIN, F.G, F.bid, DM / 64);
            EpiIn E{WSB(F), OUTB(F), l};
            pg8::gemm_phase<EpiIn, pg8::StaticOrder, true, true>(F.lds, g, S, E);
            if (l == 0) convert_weights(F, 0, ((MT / 256) * (NIN / 256)) % F.G, CV_O, CV_UP);
        } SEAM(p0);
        if (PHEN(2) && IN(p0 + 1)) { mixer_phase(F, l); } SEAM(p0 + 1);
        if (PHEN(3) && IN(p0 + 2)) {
            pg8::Gemm g{(const bf16*)(WSB(F) + WS_MG), (const bf16*)(WSB(F) + WS_WO + l * 8 * MiB), MT, DM, DM, F.wave}; pg8::SplitOrder S; S.init(MP, MS, DM, F.G, F.bid, DM / 64, NSPLIT);
            EpiRes E{OUTB(F), WSB(F), 0, false};
            pg8::gemm_phase<EpiRes, pg8::SplitOrder, true, true>(F.lds, g, S, E);
        } SEAM(p0 + 2);
        if (PHEN(4) && IN(p0 + 3)) { reduce_phase(F, 0, false); } SEAM(p0 + 3);
        if (PHEN(5) && IN(p0 + 4)) {
            zero_rss(F, 1);
            pg8::Gemm g{(const bf16*)(WSB(F) + WS_XN), (const bf16*)(WSB(F) + WS_WUP + l * 43 * MiB), MT, NUP, DM, F.wave}; pg8::StaticOrder S; S.init(MT, NUP, F.G, F.bid, DM / 64);
            EpiUp E{WSB(F), l};
            pg8::gemm_phase<EpiUp, pg8::StaticOrder, true, true>(F.lds, g, S, E);
            if (l == 0) convert_weights(F, 1, ((MT / 256) * (NUP / 256)) % F.G, 0, CV_ALL);
        } SEAM(p0 + 4);
        if (PHEN(6) && IN(p0 + 5)) { fix_phase(F, l); } SEAM(p0 + 5);
        if (PHEN(7) && IN(p0 + 6)) {
            pg8::Gemm g{(const bf16*)(WSB(F) + WS_ACT), (const bf16*)(WSB(F) + WS_WDN + l * 22 * MiB), MT, DM, DFF, F.wave}; pg8::SplitOrder S; S.init(MP, MS, DM, F.G, F.bid, DFF / 64, NSPLIT);
            EpiRes E{OUTB(F), WSB(F), 1, l + 1 == DEPTH};
            pg8::gemm_phase<EpiRes, pg8::SplitOrder, true, true>(F.lds, g, S, E);
        } SEAM(p0 + 6);
        if (PHEN(4) && IN(p0 + 7)) { reduce_phase(F, 1, l + 1 == DEPTH); } SEAM(p0 + 7);
    }
#undef IN
#undef SEAM
}

extern "C" void kernel_launch(void* const* d_in, const int* in_sizes, int n_in, void* d_out, int out_size, void* d_ws, size_t ws_size, hipStream_t stream) {
    static int grid = 0;
    if (grid == 0) {
        if (n_in != 22 || (size_t)out_size != O_END || ws_size < WS_END) { fprintf(stderr, "kernel_launch: unexpected shapes (n_in %d out %d ws %zu)\n", n_in, out_size, ws_size); grid = -1; return; }
        if (hipFuncSetAttribute((const void*)mk_fwd, hipFuncAttributeMaxDynamicSharedMemorySize, LDS_BYTES) != hipSuccess) { fprintf(stderr, "hipFuncSetAttribute failed\n"); grid = -1; return; }
        int dev = 0, cus = 0, per_cu = 0;
        (void)hipGetDevice(&dev); (void)hipDeviceGetAttribute(&cus, hipDeviceAttributeMultiprocessorCount, dev);
        (void)hipOccupancyMaxActiveBlocksPerMultiprocessor(&per_cu, (const void*)mk_fwd, 512, LDS_BYTES);
        if (per_cu < 1) per_cu = 1;
        grid = cus > 0 ? cus : 256;
        (void)hipGetLastError();
    }
    if (grid < 0) return;
    if (hipMemsetAsync(d_ws, 0, 65536, stream) != hipSuccess) { fprintf(stderr, "memset failed\n"); return; }
    Args a{};
    for (int i = 0; i < 22; ++i) a.in[i] = (const float*)d_in[i];
    a.out = (float*)d_out; a.ws = (unsigned char*)d_ws;
    for (int t = 0; t < 8; ++t) a.rep[t] = 1 + (((MK_DUP) >> t) & 1) * (t == 7 ? 2 : 1);
    constexpr int NL = MK_N_LAUNCHES;
    if (NL == 1) {
        a.ph_lo = 0; a.ph_hi = 1 + 8 * DEPTH;
        void* kargs[] = {&a};
        hipError_t e = hipLaunchCooperativeKernel((const void*)mk_fwd, dim3(grid), dim3(512), kargs, LDS_BYTES, stream);
        if (e != hipSuccess) fprintf(stderr, "cooperative launch failed: %s (grid %d)\n", hipGetErrorString(e), grid);
    } else {
        for (int p = 0; p < 1 + 8 * DEPTH; ++p) { if (p == 8 * DEPTH) break;
            a.ph_lo = p; a.ph_hi = p + 1;
            hipLaunchKernelGGL(mk_fwd, dim3(grid), dim3(512), LDS_BYTES, stream, a); }
    }
}
```

```cpp
#include <hip/hip_runtime.h>
#include <hip/hip_cooperative_groups.h>
#include <cstdio>
#include <cstdint>
namespace cg = cooperative_groups;
#define MK_DUP 0
#define MK_MIXDUP 0
namespace pg8 {
#define PG8_LAS __attribute__((address_space(3)))
typedef unsigned short bf16_t;
typedef short bf16x8 __attribute__((ext_vector_type(8)));
typedef float f32x4 __attribute__((ext_vector_type(4)));
typedef unsigned u32x4 __attribute__((ext_vector_type(4)));
constexpr int BM = 256, BK = 64, HALF = 128, HTB = HALF * BK * 2  , STAGE_BYTES = 8 * HTB, NXCD = 8, WGM = 8;

__host__ __device__ __forceinline__ int lds_byte(int r, int c) { const int st = (r >> 4) * 2 + (c >> 5), rr = r & 15, cc = c & 31, ob = rr * 64 + cc * 2; return st * 1024 + (ob ^ (((ob >> 9) & 1) << 5)); }
__host__ __device__ __forceinline__ void stage_rc(int b, int& R, int& C) { const int st = b / 1024, sb = b % 1024, swz = sb ^ (((sb >> 9) & 1) << 5); R = (st >> 1) * 16 + swz / 64; C = (st & 1) * 32 + (swz % 64) / 2; }
__host__ __device__ __forceinline__ int perm32(int rho) { const int n = rho >> 4, i = rho & 15; return 8 * (i >> 2) + 4 * n + (i & 3); }

struct Unit { int pm, pn, k0, nt, sp; };
struct Gemm { const bf16_t* A; const bf16_t* Bt; int M, N, K, wave; };

struct StaticOrder {
    int nM, nN, nwg, G, c, ntK;
    __host__ __device__ void init(int M, int N, int G_, int c_, int ntK_) { nM = M / BM; nN = N / BM; nwg = nM * nN; G = G_; c = c_; ntK = ntK_; }
    __host__ __device__ bool next(int i, Unit& u) const {
        const long L = (long)i * G + c; if (L >= nwg) return false;
        int wgid = (int)L; { const int q = nwg / NXCD, r = nwg % NXCD, xcd = wgid % NXCD, off = wgid / NXCD; wgid = (xcd < r ? xcd * (q + 1) : r * (q + 1) + (xcd - r) * q) + off; }
        const int nig = WGM * nN, gid = wgid / nig, fm = gid * WGM, gsz = (nM - fm) < WGM ? (nM - fm) : WGM;
        u.pm = fm + ((wgid % nig) % gsz); u.pn = (wgid % nig) / gsz; u.k0 = 0; u.nt = ntK; u.sp = 0; return true;
    }
    __device__ __forceinline__ void a_ready(const Unit&) const {}
    __device__ __forceinline__ void done(const Unit&) const {}
};


struct SplitOrder {
    StaticOrder main; int nMmain, nMtail, nsplit;
    __host__ __device__ void init(int Mmain, int Mtail, int N, int G_, int c_, int ntK_, int nsplit_) { main.init(Mmain, N, G_, c_, ntK_); nMmain = Mmain / BM; nMtail = Mtail / BM; nsplit = nsplit_; }
    __host__ __device__ bool next(int i, Unit& u) const {
        const long L = (long)i * main.G + main.c;
        if (L < main.nwg) return main.next(i, u);
        const int j = (int)(L - main.nwg), nu = nMtail * main.nN; if (j >= nu * nsplit) return false;
        const int un = j % nu, sp = j / nu, iters = main.ntK / 2, i0 = (iters * sp) / nsplit, i1 = (iters * (sp + 1)) / nsplit;
        u.pm = nMmain + un / main.nN; u.pn = un % main.nN; u.k0 = 2 * i0; u.nt = 2 * (i1 - i0); u.sp = sp; return true;
    }
    __device__ __forceinline__ void a_ready(const Unit&) const {}
    __device__ __forceinline__ void done(const Unit&) const {}
};
template <class Epi, class Sched, bool ALIGN_EPI = false, bool SP2 = false>
__device__ __forceinline__ void gemm_phase(PG8_LAS unsigned char* lds, const Gemm g, const Sched& S, const Epi& E) {
    int tid_o = (int)__builtin_amdgcn_mbcnt_hi(~0u, __builtin_amdgcn_mbcnt_lo(~0u, 0u)); asm volatile("" : "+v"(tid_o)); tid_o += 64 * g.wave;
    const int tid = tid_o, wid = __builtin_amdgcn_readfirstlane(tid >> 6), lane = tid & 63, wr = wid >> 2, wc = wid & 3, fr = lane & 15, fq = lane >> 4;
    const int K = g.K;
    unsigned voffA[2], voffB[2];
#pragma unroll
    for (int i = 0; i < 2; ++i) { int R, C; stage_rc(tid * 16 + i * 8192, R, C); const int Rb = Epi::PERM ? ((R & ~31) + perm32(R & 31)) : R;
        const int Ra = (R & ~63) | ((R & 15) << 2) | ((R >> 4) & 3);
        voffA[i] = (unsigned)(Ra * K + C) * 2u; voffB[i] = (unsigned)(Rb * K + C) * 2u; }
    const size_t kstep = (size_t)(BK * 2);
    const size_t hstep = (size_t)HALF * K * 2;
    const size_t tstep = 2 * hstep;
    const unsigned ldsw = (unsigned)wid * 1024u;
    const int aoff = lds_byte(wr * 64 + fr, fq * 8), boff = lds_byte(wc * 32 + fr, fq * 8);
#define PG8_SA(b, h) (((b) * 2 + (h)) * HTB)
#define PG8_SB(b, h) ((4 + (b) * 2 + (h)) * HTB)
#define PG8_STAGE(bufoff, gbase, voff) do { _Pragma("unroll") for (int _i = 0; _i < 2; ++_i) \
        __builtin_amdgcn_global_load_lds((const unsigned*)((const char*)(gbase) + (voff)[_i]), (PG8_LAS unsigned*)(lds + (bufoff) + ldsw + _i * 8192), 16, 0, 0); } while (0)
#define PG8_LDA(dst, b, h) do { _Pragma("unroll") for (int m = 0; m < 4; ++m) _Pragma("unroll") for (int k = 0; k < 2; ++k) dst[m][k] = *(const PG8_LAS bf16x8*)(lds + PG8_SA(b, h) + aoff + m * 2048 + k * 1024); } while (0)
#define PG8_LDB(dst, b, h) do { _Pragma("unroll") for (int n = 0; n < 2; ++n) _Pragma("unroll") for (int k = 0; k < 2; ++k) dst[n][k] = *(const PG8_LAS bf16x8*)(lds + PG8_SB(b, h) + boff + n * 2048 + k * 1024); } while (0)
#define PG8_MMA(ai, bj, At, Bt) do { __builtin_amdgcn_s_setprio(1); _Pragma("unroll") for (int m = 0; m < 4; ++m) _Pragma("unroll") for (int n = 0; n < 2; ++n) _Pragma("unroll") for (int k = 0; k < 2; ++k) \
        acc[ai][bj][m][n] = __builtin_amdgcn_mfma_f32_16x16x32_bf16(Bt[n][k], At[m][k], acc[ai][bj][m][n], 0, 0, 0); __builtin_amdgcn_s_setprio(0); } while (0)
#define PG8_WAIT_V(n) asm volatile("s_waitcnt vmcnt(" #n ")" ::: "memory")
#define PG8_WAIT_L(n) asm volatile("s_waitcnt lgkmcnt(" #n ")" ::: "memory")
#define PG8_BAR __builtin_amdgcn_s_barrier()
#define PG8_SCHED __builtin_amdgcn_sched_barrier(0)
    Unit cur, nxt; int ui = 0;
    if (!S.next(0, cur)) return;
    f32x4 acc[2][2][4][2];
#pragma unroll
    for (int a = 0; a < 2; ++a)
#pragma unroll
        for (int b = 0; b < 2; ++b)
#pragma unroll
            for (int m = 0; m < 4; ++m)
#pragma unroll
                for (int n = 0; n < 2; ++n) acc[a][b][m][n] = (f32x4){0.f, 0.f, 0.f, 0.f};
    bf16x8 At[4][2], B0[2][2], B1[2][2];
    const char* cA = (const char*)g.A + (size_t)cur.pm * tstep + (size_t)cur.k0 * kstep; const char* cB = (const char*)g.Bt + (size_t)cur.pn * tstep + (size_t)cur.k0 * kstep;
    S.a_ready(cur);
    if constexpr (SP2) {
        PG8_STAGE(PG8_SB(0, 0), cB, voffB); PG8_STAGE(PG8_SB(0, 1), cB + hstep, voffB); PG8_STAGE(PG8_SA(0, 0), cA, voffA); PG8_STAGE(PG8_SA(0, 1), cA + hstep, voffA);
        if (wr == 1) PG8_BAR;
        PG8_WAIT_V(2); PG8_BAR;
        PG8_STAGE(PG8_SB(1, 0), cB + kstep, voffB); PG8_STAGE(PG8_SA(1, 0), cA + kstep, voffA); PG8_STAGE(PG8_SB(1, 1), cB + hstep + kstep, voffB);
        PG8_WAIT_V(6); PG8_BAR;
    } else {
        PG8_STAGE(PG8_SB(0, 0), cB, voffB); PG8_STAGE(PG8_SA(0, 0), cA, voffA); PG8_STAGE(PG8_SB(0, 1), cB + hstep, voffB); PG8_STAGE(PG8_SA(0, 1), cA + hstep, voffA);
        if (wr == 1) PG8_BAR;
        PG8_WAIT_V(4); PG8_BAR;
        PG8_STAGE(PG8_SB(1, 0), cB + kstep, voffB); PG8_STAGE(PG8_SA(1, 0), cA + kstep, voffA); PG8_STAGE(PG8_SB(1, 1), cB + hstep + kstep, voffB);
        PG8_WAIT_V(6); PG8_BAR;
    }
    for (;;) {
        const bool has_next = S.next(ui + 1, nxt);
        const char* nA = has_next ? (const char*)g.A + (size_t)nxt.pm * tstep + (size_t)nxt.k0 * kstep : cA; const char* nB = has_next ? (const char*)g.Bt + (size_t)nxt.pn * tstep + (size_t)nxt.k0 * kstep : cB;
        const int nt = cur.nt;
        for (int t = 0; t < nt; t += 2) {
            const bool last = (t == nt - 2);
            const char* a1 = cA + (size_t)(t + 1) * kstep;
            const char* a2 = last ? nA : cA + (size_t)(t + 2) * kstep; const char* b2 = last ? nB : cB + (size_t)(t + 2) * kstep;
            const char* a3 = a2 + kstep; const char* b3 = b2 + kstep;
            if (last && has_next) S.a_ready(nxt);
            if constexpr (SP2) {
            PG8_LDB(B0, 0, 0); PG8_LDB(B1, 0, 1); PG8_SCHED; PG8_LDA(At, 0, 0); PG8_STAGE(PG8_SA(1, 1), a1 + hstep, voffA);
            PG8_WAIT_V(8); PG8_WAIT_L(0); PG8_BAR; PG8_MMA(0, 0, At, B0); PG8_MMA(0, 1, At, B1); PG8_BAR; PG8_SCHED;
            PG8_LDA(At, 0, 1); PG8_STAGE(PG8_SB(0, 0), b2, voffB); PG8_STAGE(PG8_SB(0, 1), b2 + hstep, voffB); PG8_STAGE(PG8_SA(0, 0), a2, voffA);
            PG8_WAIT_V(8); PG8_WAIT_L(0); PG8_BAR; PG8_MMA(1, 0, At, B0); PG8_MMA(1, 1, At, B1); PG8_BAR; PG8_SCHED;
            PG8_LDB(B0, 1, 0); PG8_LDB(B1, 1, 1); PG8_SCHED; PG8_LDA(At, 1, 0); PG8_STAGE(PG8_SA(0, 1), a2 + hstep, voffA);
            PG8_WAIT_V(8); PG8_WAIT_L(0); PG8_BAR; PG8_MMA(0, 0, At, B0); PG8_MMA(0, 1, At, B1); PG8_BAR; PG8_SCHED;
            PG8_LDA(At, 1, 1); PG8_STAGE(PG8_SB(1, 0), b3, voffB); PG8_STAGE(PG8_SB(1, 1), b3 + hstep, voffB); PG8_STAGE(PG8_SA(1, 0), a3, voffA);
            PG8_WAIT_V(8); PG8_WAIT_L(0); PG8_BAR; PG8_MMA(1, 0, At, B0); PG8_MMA(1, 1, At, B1); PG8_BAR; PG8_SCHED;
            } else {
            PG8_LDB(B0, 0, 0); PG8_SCHED; PG8_LDA(At, 0, 0); PG8_STAGE(PG8_SA(1, 1), a1 + hstep, voffA);
            PG8_WAIT_L(8); PG8_BAR; PG8_WAIT_L(0); PG8_MMA(0, 0, At, B0); PG8_BAR; PG8_SCHED;
            PG8_LDB(B1, 0, 1); PG8_STAGE(PG8_SB(0, 0), b2, voffB);
            PG8_BAR; PG8_WAIT_L(0); PG8_MMA(0, 1, At, B1); PG8_BAR;
            PG8_LDA(At, 0, 1); PG8_STAGE(PG8_SA(0, 0), a2, voffA);
            PG8_BAR; PG8_WAIT_L(0); PG8_MMA(1, 0, At, B0); PG8_BAR; PG8_SCHED;
            PG8_STAGE(PG8_SB(0, 1), b2 + hstep, voffB);
            PG8_WAIT_V(6); PG8_BAR; PG8_MMA(1, 1, At, B1); PG8_BAR;
            PG8_LDB(B0, 1, 0); PG8_SCHED; PG8_LDA(At, 1, 0); PG8_STAGE(PG8_SA(0, 1), a2 + hstep, voffA);
            PG8_WAIT_L(8); PG8_BAR; PG8_WAIT_L(0); PG8_MMA(0, 0, At, B0); PG8_BAR; PG8_SCHED;
            PG8_LDB(B1, 1, 1); PG8_STAGE(PG8_SB(1, 0), b3, voffB);
            PG8_BAR; PG8_WAIT_L(0); PG8_MMA(0, 1, At, B1); PG8_BAR;
            PG8_LDA(At, 1, 1); PG8_STAGE(PG8_SA(1, 0), a3, voffA);
            PG8_BAR; PG8_WAIT_L(0); PG8_MMA(1, 0, At, B0); PG8_BAR; PG8_SCHED;
            PG8_STAGE(PG8_SB(1, 1), b3 + hstep, voffB);
            PG8_WAIT_V(6); PG8_BAR; PG8_MMA(1, 1, At, B1); PG8_BAR;
            }
        }
        if constexpr (ALIGN_EPI) { if (wr == 0) PG8_BAR; }
        if constexpr (!Epi::AFTER_DRAIN) { E(acc, cur, wr, wc, fr, fq); S.done(cur); }
        if (!has_next) break;
#pragma unroll
        for (int a = 0; a < 2; ++a)
#pragma unroll
            for (int b = 0; b < 2; ++b)
#pragma unroll
                for (int m = 0; m < 4; ++m)
#pragma unroll
                    for (int n = 0; n < 2; ++n) acc[a][b][m][n] = (f32x4){0.f, 0.f, 0.f, 0.f};
        cur = nxt; cA = nA; cB = nB; ++ui;
        if constexpr (ALIGN_EPI) { if (wr == 1) PG8_BAR; }
    }
    PG8_WAIT_V(0);
    if constexpr (!ALIGN_EPI) { if (wr == 0) PG8_BAR; }
    PG8_BAR;
    if constexpr (Epi::AFTER_DRAIN) { E.fused(acc, cur, wr, wc, fr, fq, lds, wid, lane); S.done(cur); }
#undef PG8_SA
#undef PG8_SB
#undef PG8_STAGE
#undef PG8_LDA
#undef PG8_LDB
#undef PG8_MMA
#undef PG8_WAIT_V
#undef PG8_WAIT_L
#undef PG8_BAR
#undef PG8_SCHED
}
}

#ifndef MK_N_LAUNCHES
#define MK_N_LAUNCHES 1
#endif
#ifndef MK_PHMASK
#define MK_PHMASK 0x3ff
#endif
#define PHEN(t) (((MK_PHMASK) >> (t)) & 1)
#ifndef MK_DUP
#define MK_DUP 0
#endif
#ifndef MK_MIXDUP
#define MK_MIXDUP 0
#endif
#define REP(t, l) _Pragma("unroll 1") for (int rep_ = 0, nrep_ = ((l) == 0 ? KARG_I(200 + 4 * (t)) : 1); rep_ < nrep_; ++rep_)
constexpr int DM = 2048, MP = 16384, MS = 512, MT = MP + MS, SEQ = 2048, NIN = 3328, DFF = 5504, NUP = 11008;
constexpr int DEPTH = 2, NPH = 16;
constexpr float EPS = 1e-6f, LOG2E = 1.4426950408889634f;
constexpr size_t MiB = 1u << 20;
constexpr size_t SZ_WIN = (size_t)NIN * DM * 2, SZ_WO = (size_t)DM * DM * 2, SZ_WUP = (size_t)NUP * DM * 2, SZ_WDN = (size_t)DM * DFF * 2;
constexpr size_t WS_WIN = 1 * MiB, WS_WO = WS_WIN + 2 * 13 * MiB, WS_WUP = WS_WO + 2 * 8 * MiB, WS_WDN = WS_WUP + 2 * 43 * MiB;
constexpr size_t WS_XN = WS_WDN + 2 * 22 * MiB;
constexpr size_t WS_ACT = WS_XN + 66 * MiB;
constexpr size_t WS_Q = WS_ACT, WS_U = WS_Q + 33 * MiB, WS_VS = WS_U + 33 * MiB, WS_K = WS_VS + 33 * MiB, WS_V = WS_K + 5 * MiB, WS_MG = WS_V + 5 * MiB;
constexpr size_t WS_BND = WS_ACT + 178 * MiB;
constexpr size_t WS_HS = WS_BND + 43 * MiB;
constexpr size_t WS_PART = WS_HS + 22 * MiB;
constexpr size_t WS_END = WS_PART + 32 * MiB;
constexpr size_t WS_RSS = 256 * 1024;
constexpr int NSPLIT = 8;
static_assert(WS_MG + 66 * MiB <= WS_BND && SZ_WIN <= 13 * MiB && SZ_WO <= 8 * MiB && SZ_WUP <= 43 * MiB && SZ_WDN <= 22 * MiB, "ws map");
constexpr size_t O_YS = (size_t)MP * DM, O_KP = O_YS + (size_t)MS * DM, O_VP = O_KP + 262144, O_CP = O_VP + 262144, O_KS = O_CP + 352256, O_VSO = O_KS + 4194304,
                 O_CS = O_VSO + 4194304, O_SV = O_CS + 5636096, O_END = O_SV + 1048576;
constexpr int LDS_BYTES = 147456;
constexpr int CW_BAR = 4096;
constexpr int KS_OFF = 0, KS_STRIDE = 144, VT_OFF = 55296, VT_STRIDE = 400, ST_OFF = 110592;
constexpr int SG_WAVE = 32 * 272;

#define GAS __attribute__((address_space(1)))
#define LAS __attribute__((address_space(3)))
#define RLX_AGENT __ATOMIC_RELAXED, __HIP_MEMORY_SCOPE_AGENT
#define DI __device__ __forceinline__
typedef unsigned short bf16;
typedef unsigned v4u __attribute__((ext_vector_type(4)));
typedef unsigned v2u __attribute__((ext_vector_type(2)));
typedef float f32x4 __attribute__((ext_vector_type(4)));
typedef float f32x16 __attribute__((ext_vector_type(16)));
typedef short bf16x8 __attribute__((ext_vector_type(8)));
typedef short s16x4 __attribute__((ext_vector_type(4)));
#define MFMA32(a, b, c) __builtin_amdgcn_mfma_f32_32x32x16_bf16((a), (b), (c), 0, 0, 0)
#define LDS_WAIT() asm volatile("s_waitcnt lgkmcnt(0)" ::: "memory")

DI unsigned pk2(float lo, float hi) { unsigned r; asm volatile("v_cvt_pk_bf16_f32 %0, %1, %2" : "=v"(r) : "v"(lo), "v"(hi)); return r; }
DI float bflo(unsigned w) { return __uint_as_float(w << 16); }
DI float bfhi(unsigned w) { return __uint_as_float(w & 0xffff0000u); }
DI float fexp2(float x) { return __builtin_amdgcn_exp2f(x); }
DI float frcp(float x) { return __builtin_amdgcn_rcpf(x); }
DI float frsq(float x) { return __builtin_amdgcn_rsqf(x); }
DI float gelu_t(float x) { const float t = x * (1.0f + 0.044715f * x * x); return x * frcp(1.0f + fexp2(-2.302208198f * t)); }
DI float silu(float x) { return x * frcp(1.0f + fexp2(-LOG2E * x)); }
DI float wave_sum(float v) {
#pragma unroll
    for (int o = 1; o < 64; o <<= 1) v += __shfl_xor(v, o);
    return v;
}
DI int crow(int reg, int h) { return (reg & 3) + 8 * (reg >> 2) + 4 * h; }
DI float dpp_ror1(float s) { return __builtin_bit_cast(float, __builtin_amdgcn_update_dpp(0, __builtin_bit_cast(int, s), 0x121, 0xf, 0xf, false)); }
DI float dpp_ror2(float s) { return __builtin_bit_cast(float, __builtin_amdgcn_update_dpp(0, __builtin_bit_cast(int, s), 0x122, 0xf, 0xf, false)); }
DI float dpp_shr1(float o, float s) { return __builtin_bit_cast(float, __builtin_amdgcn_update_dpp(__builtin_bit_cast(int, o), __builtin_bit_cast(int, s), 0x111, 0xf, 0xf, false)); }
DI float dpp_shr2(float o, float s) { return __builtin_bit_cast(float, __builtin_amdgcn_update_dpp(__builtin_bit_cast(int, o), __builtin_bit_cast(int, s), 0x112, 0xf, 0xf, false)); }

struct Args { const float* in[22]; float* out; unsigned char* ws; int ph_lo, ph_hi; int rep[8]; };
struct Frame {
    LAS unsigned char* lds; int tid, lane, wave, G, bid;
    float* out; unsigned char* ws;
};
DI const float* INP(int k) { const char __attribute__((address_space(4)))* p = (const char __attribute__((address_space(4)))*)__builtin_amdgcn_kernarg_segment_ptr(); asm volatile("" : "+s"(p)); return (const float*)(((const GAS float* const __attribute__((address_space(4)))*)p)[k]); }
DI Frame opaque(const Frame& F0) { Frame F = F0; int ln = (int)__builtin_amdgcn_mbcnt_hi(~0u, __builtin_amdgcn_mbcnt_lo(~0u, 0u)); asm volatile("" : "+v"(ln)); F.lane = ln; F.tid = F0.wave * 64 + ln; return F; }
DI int KARG_I(int byteoff) { const char __attribute__((address_space(4)))* p = (const char __attribute__((address_space(4)))*)__builtin_amdgcn_kernarg_segment_ptr(); asm volatile("" : "+s"(p)); return *(const int __attribute__((address_space(4)))*)(p + byteoff); }
DI unsigned char* WSB(const Frame& F) { GAS unsigned char* p = (GAS unsigned char*)F.ws; asm volatile("" : "+s"(p)); return (unsigned char*)p; }
DI float* OUTB(const Frame& F) { GAS float* p = (GAS float*)F.out; asm volatile("" : "+s"(p)); return (float*)p; }

struct EpiIn {
    static constexpr bool PERM = false, AFTER_DRAIN = false;
    unsigned char* ws; float* out; int l;
    DI void operator()(const f32x4 (&acc)[2][2][4][2], const pg8::Unit& u, int wr, int wc, int fr, int fq) const {
        bf16 *Q = (bf16*)(ws + WS_Q), *Kb = (bf16*)(ws + WS_K), *Vb = (bf16*)(ws + WS_V), *U = (bf16*)(ws + WS_U), *VS = (bf16*)(ws + WS_VS);
        const float *gq = INP(7) + l * 64, *gk = INP(8) + l * 64; const float* rss = (const float*)(ws + WS_RSS) + MT;
        float *kwp = out + O_KP + (size_t)l * 131072, *vwp = out + O_VP + (size_t)l * 131072, *kws = out + O_KS + (size_t)l * 2097152, *vws = out + O_VSO + (size_t)l * 2097152;
        const int pn = u.pn;
        const bool isq = pn < 4, iskv = pn == 4, isk = iskv && wc < 2;
        f32x4 g[2][2];
        const float* gp = isq ? gq : gk;
#pragma unroll
        for (int bj = 0; bj < 2; ++bj)
#pragma unroll
            for (int n = 0; n < 2; ++n) g[bj][n] = (isq || isk) ? *(const f32x4*)(gp + 32 * bj + 8 * fq + 4 * n) : (f32x4){1.f, 1.f, 1.f, 1.f};
        f32x4 rsq4[2];
#pragma unroll
        for (int ai = 0; ai < 2; ++ai) rsq4[ai] = *(const f32x4*)(rss + u.pm * 256 + ai * 128 + wr * 64 + fr * 4);
        bf16* obase; int ld;
        if (isq) { obase = Q + pn * 256 + wc * 64; ld = 1024; }
        else if (iskv) { obase = (wc < 2 ? Kb : Vb) + (wc & 1) * 64; ld = 128; }
        else if (pn < 9) { obase = U + (pn - 5) * 256 + wc * 64; ld = 1024; }
        else { obase = VS + (pn - 9) * 256 + wc * 64; ld = 1024; }
#pragma unroll
        for (int ai = 0; ai < 2; ++ai)
#pragma unroll
            for (int m = 0; m < 4; ++m) {
                const int row = u.pm * 256 + ai * 128 + wr * 64 + fr * 4 + m;
                const float rsx = frsq(rsq4[ai][m] * (1.0f / DM) + EPS);
                f32x4 v[2][2];
#pragma unroll
                for (int bj = 0; bj < 2; ++bj)
#pragma unroll
                    for (int n = 0; n < 2; ++n) v[bj][n] = acc[ai][bj][m][n] * rsx;
                if (isq || isk) {
                    float ss = 0.f;
#pragma unroll
                    for (int bj = 0; bj < 2; ++bj)
#pragma unroll
                        for (int n = 0; n < 2; ++n) { const f32x4 x = v[bj][n]; ss += (x[0] * x[0] + x[1] * x[1]) + (x[2] * x[2] + x[3] * x[3]); }
                    ss += __shfl_xor(ss, 16); ss += __shfl_xor(ss, 32);
                    const float rs = frsq(ss * (1.0f / 64.0f) + EPS);
#pragma unroll
                    for (int bj = 0; bj < 2; ++bj)
#pragma unroll
                        for (int n = 0; n < 2; ++n) v[bj][n] = v[bj][n] * rs * g[bj][n];
                } else if (!iskv) {
#pragma unroll
                    for (int bj = 0; bj < 2; ++bj)
#pragma unroll
                        for (int n = 0; n < 2; ++n)
#pragma unroll
                            for (int e = 0; e < 4; ++e) v[bj][n][e] = gelu_t(v[bj][n][e]);
                }
                bf16* rowp = obase + (size_t)row * ld + 8 * fq;
#pragma unroll
                for (int bj = 0; bj < 2; ++bj) { v4u w; w.x = pk2(v[bj][0][0], v[bj][0][1]); w.y = pk2(v[bj][0][2], v[bj][0][3]); w.z = pk2(v[bj][1][0], v[bj][1][1]); w.w = pk2(v[bj][1][2], v[bj][1][3]);
                    *(v4u*)(rowp + 32 * bj) = w; }
                if (iskv) {
                    float* wb = nullptr;
                    if (row < MP) { const int t = row & (SEQ - 1); if (t >= SEQ - 128) wb = (wc < 2 ? kwp : vwp) + ((size_t)((row >> 11) * 128 + (t - (SEQ - 128))) * 2 + (wc & 1)) * 64; }
                    else { const int sr = row - MP; wb = (wc < 2 ? kws : vws) + ((size_t)((sr >> 2) * 128 + 124 + (sr & 3)) * 2 + (wc & 1)) * 64; }
                    if (wb) {
#pragma unroll
                        for (int bj = 0; bj < 2; ++bj)
#pragma unroll
                            for (int n = 0; n < 2; ++n) *(f32x4*)(wb + 32 * bj + 8 * fq + 4 * n) = v[bj][n];
                    }
                }
            }
    }
};
struct EpiRes {
    static constexpr bool PERM = false, AFTER_DRAIN = false;
    float* out; unsigned char* ws; int rsel; bool fin;
    DI void operator()(const f32x4 (&acc)[2][2][4][2], const pg8::Unit& u, int wr, int wc, int fr, int fq) const {
        const int col0 = u.pn * 256 + wc * 32 + 8 * fq;
        if (u.pm >= MP / 256) {
            float* P = (float*)(ws + WS_PART) + (size_t)u.sp * MS * DM;
#pragma unroll
            for (int ai = 0; ai < 2; ++ai)
#pragma unroll
                for (int m = 0; m < 4; ++m) { const size_t off = (size_t)((u.pm - MP / 256) * 256 + ai * 128 + wr * 64 + fr * 4 + m) * DM + col0;
#pragma unroll
                    for (int bj = 0; bj < 2; ++bj)
#pragma unroll
                        for (int n = 0; n < 2; ++n) *(f32x4*)(P + off + bj * 128 + n * 4) = acc[ai][bj][m][n]; }
            return;
        }
        bf16* XN = (bf16*)(ws + WS_XN); float* rss = (float*)(ws + WS_RSS) + rsel * MT;
#pragma unroll
        for (int ai = 0; ai < 2; ++ai) {
            v4u rw[1][4][2];
#pragma unroll
            for (int m = 0; m < 4; ++m)
#pragma unroll
                for (int bj = 0; bj < 2; ++bj) rw[0][m][bj] = *(const v4u*)(XN + (size_t)(u.pm * 256 + ai * 128 + wr * 64 + fr * 4 + m) * DM + col0 + bj * 128);
            asm volatile("" ::: "memory");
#pragma unroll
            for (int m = 0; m < 4; ++m) { const int row = u.pm * 256 + ai * 128 + wr * 64 + fr * 4 + m; const size_t off = (size_t)row * DM + col0; float ss = 0.f;
#pragma unroll
                for (int bj = 0; bj < 2; ++bj) { const v4u r4 = rw[0][m][bj];
                    const f32x4 x0 = (f32x4){bflo(r4.x), bfhi(r4.x), bflo(r4.y), bfhi(r4.y)} + acc[ai][bj][m][0], x1 = (f32x4){bflo(r4.z), bfhi(r4.z), bflo(r4.w), bfhi(r4.w)} + acc[ai][bj][m][1];
                    if (fin) { *(f32x4*)(out + off + bj * 128) = x0; *(f32x4*)(out + off + bj * 128 + 4) = x1; }
                    else { ss += (x0[0] * x0[0] + x0[1] * x0[1]) + (x0[2] * x0[2] + x0[3] * x0[3]) + (x1[0] * x1[0] + x1[1] * x1[1]) + (x1[2] * x1[2] + x1[3] * x1[3]);
                        v4u w; w.x = pk2(x0[0], x0[1]); w.y = pk2(x0[2], x0[3]); w.z = pk2(x1[0], x1[1]); w.w = pk2(x1[2], x1[3]); *(v4u*)(XN + off + bj * 128) = w; } }
                if (!fin) { ss += __shfl_xor(ss, 16); ss += __shfl_xor(ss, 32); if (fq == 0) unsafeAtomicAdd(rss + row, ss); } }
        }
    }
};
DI float dpp_up1(float s) { return __builtin_bit_cast(float, __builtin_amdgcn_update_dpp(0, __builtin_bit_cast(int, s), 0x111, 0xf, 0xf, true)); }
struct EpiUp {
    static constexpr bool PERM = false, AFTER_DRAIN = false;
    unsigned char* ws; int l;
    DI void operator()(f32x4 (&acc)[2][2][4][2], const pg8::Unit& u, int wr, int wc, int fr, int fq) const {
        bf16* ACT = (bf16*)(ws + WS_ACT); float *BND = (float*)(ws + WS_BND), *HS = (float*)(ws + WS_HS);
        const float *cw = INP(19) + (size_t)l * 3 * NUP, *cb = INP(20) + (size_t)l * NUP; const float* rss = (const float*)(ws + WS_RSS);
        const int cbase = 128 * u.pn + 32 * wc + 8 * fq;
#pragma unroll
        for (int ai = 0; ai < 2; ++ai) { const f32x4 q = *(const f32x4*)(rss + u.pm * 256 + ai * 128 + wr * 64 + fr * 4);
#pragma unroll
            for (int m = 0; m < 4; ++m) { const float rs = frsq(q[m] * (1.0f / DM) + EPS);
#pragma unroll
                for (int bj = 0; bj < 2; ++bj)
#pragma unroll
                    for (int n = 0; n < 2; ++n) acc[ai][bj][m][n] *= rs; } }
        if (u.pm >= MP / 256) {
#pragma unroll
            for (int ai = 0; ai < 2; ++ai)
#pragma unroll
                for (int m = 0; m < 4; ++m) { float* hp = HS + (size_t)((u.pm - MP / 256) * 256 + ai * 128 + wr * 64 + fr * 4 + m) * NUP + cbase;
#pragma unroll
                    for (int bj = 0; bj < 2; ++bj)
#pragma unroll
                        for (int n = 0; n < 2; ++n) *(f32x4*)(hp + bj * DFF + 4 * n) = acc[ai][bj][m][n]; }
            return;
        }
        v2u keep[2][4];
#pragma unroll
        for (int n = 0; n < 2; ++n) {
            const int ca = cbase + 4 * n;
            const f32x4 w0a = *(const f32x4*)(cw + ca), w1a = *(const f32x4*)(cw + NUP + ca), w2a = *(const f32x4*)(cw + 2 * NUP + ca), ba = *(const f32x4*)(cb + ca);
            const f32x4 w0g = *(const f32x4*)(cw + DFF + ca), w1g = *(const f32x4*)(cw + NUP + DFF + ca), w2g = *(const f32x4*)(cw + 2 * NUP + DFF + ca), bg = *(const f32x4*)(cb + DFF + ca);
#pragma unroll
            for (int ai = 0; ai < 2; ++ai) {
                const int row0 = u.pm * 256 + ai * 128 + wr * 64 + fr * 4;
                const f32x4 a0 = acc[ai][0][0][n], a1 = acc[ai][0][1][n], a2 = acc[ai][0][2][n], a3 = acc[ai][0][3][n];
                const f32x4 g0 = acc[ai][1][0][n], g1 = acc[ai][1][1][n], g2 = acc[ai][1][2][n], g3 = acc[ai][1][3][n];
                f32x4 am1, am2, gm1, gm2;
#pragma unroll
                for (int e = 0; e < 4; ++e) { am1[e] = dpp_up1(a3[e]); am2[e] = dpp_up1(a2[e]); gm1[e] = dpp_up1(g3[e]); gm2[e] = dpp_up1(g2[e]); }
                f32x4 ha[4], hg[4];
                ha[0] = ba + w0a * am2 + w1a * am1 + w2a * a0; ha[1] = ba + w0a * am1 + w1a * a0 + w2a * a1; ha[2] = ba + w0a * a0 + w1a * a1 + w2a * a2; ha[3] = ba + w0a * a1 + w1a * a2 + w2a * a3;
                hg[0] = bg + w0g * gm2 + w1g * gm1 + w2g * g0; hg[1] = bg + w0g * gm1 + w1g * g0 + w2g * g1; hg[2] = bg + w0g * g0 + w1g * g1 + w2g * g2; hg[3] = bg + w0g * g1 + w1g * g2 + w2g * g3;
#pragma unroll
                for (int m = 0; m < 4; ++m) { v2u w; w.x = pk2(ha[m][0] * silu(hg[m][0]), ha[m][1] * silu(hg[m][1])); w.y = pk2(ha[m][2] * silu(hg[m][2]), ha[m][3] * silu(hg[m][3]));
                    if (n == 0) keep[ai][m] = w;
                    else { v4u w4; w4.x = keep[ai][m].x; w4.y = keep[ai][m].y; w4.z = w.x; w4.w = w.y; *(v4u*)(ACT + (size_t)(row0 + m) * DFF + cbase) = w4; } }
                if (fr == 0 || fr == 15) {
                    const bool lo = fr == 0; float* bp = BND + ((size_t)(row0 >> 6) * 4 + (lo ? 0 : 2)) * NUP + ca;
                    *(f32x4*)bp = lo ? a0 : a2; *(f32x4*)(bp + DFF) = lo ? g0 : g2; *(f32x4*)(bp + NUP) = lo ? a1 : a3; *(f32x4*)(bp + NUP + DFF) = lo ? g1 : g3; }
            }
        }
    }
};

template <int MAP> DI int slot_of(int c) {
    if (MAP == 1) { const int pn = c >> 8, t = c & 255, wc = t >> 6, i = t & 63, bj = i >> 5, r32 = i & 31, fq = r32 >> 3, n = (r32 >> 2) & 1, e = r32 & 3; return pn * 256 + bj * 128 + wc * 32 + n * 16 + fq * 4 + e; }
    if (MAP == 2) { const int part = c >= DFF ? 1 : 0, j = c - part * DFF, pn = j >> 7, i = j & 127, wc = i >> 5, r32 = i & 31, fq = r32 >> 3, n = (r32 >> 2) & 1, e = r32 & 3; return pn * 256 + part * 128 + wc * 32 + n * 16 + fq * 4 + e; }
    if (MAP == 3) { const int pn = c >> 8, t = c & 255, bj = t >> 7, wc = (t >> 5) & 3, r32 = t & 31, fq = r32 >> 3, n = (r32 >> 2) & 1, e = r32 & 3; return pn * 256 + bj * 128 + wc * 32 + n * 16 + fq * 4 + e; }
    return c;
}
template <int MAP> DI void transpose_item(const float* W, const float* gk  , int K, int N, bf16* WT, LAS unsigned* scr, int item, int lane) {
    const int nblk = N / 64, kb = item / nblk, nb = item % nblk, k0 = 64 * kb, n0 = 64 * nb;
    const int q = lane & 15, kp = lane >> 4;
#pragma unroll
    for (int i = 0; i < 8; ++i) { const int kpair = kp + 4 * i; const float* p = W + (size_t)(k0 + 2 * kpair) * N + n0 + 4 * q;
        const float g0 = gk ? gk[k0 + 2 * kpair] : 1.0f, g1 = gk ? gk[k0 + 2 * kpair + 1] : 1.0f;
        const f32x4 r0 = *(const f32x4*)p * g0, r1 = *(const f32x4*)(p + N) * g1;
#pragma unroll
        for (int j = 0; j < 4; ++j) scr[(4 * q + j) * 33 + kpair] = pk2(r0[j], r1[j]); }
    LDS_WAIT();
    const int c = lane & 7;
#pragma unroll
    for (int i = 0; i < 8; ++i) { const int n = (lane >> 3) + 8 * i; const LAS unsigned* s = scr + n * 33 + 4 * c; v4u o; o.x = s[0]; o.y = s[1]; o.z = s[2]; o.w = s[3];
        *(v4u*)(WT + (size_t)slot_of<MAP>(n0 + n) * K + k0 + 8 * c) = o; }
    LDS_WAIT();
}
DI void xg_row(const float* xrow, bf16* orow, float* rss, int lane) {
    f32x4 v[8]; float s = 0.f;
#pragma unroll
    for (int j = 0; j < 8; ++j) { v[j] = *((const f32x4*)xrow + lane + 64 * j); s += (v[j][0] * v[j][0] + v[j][1] * v[j][1]) + (v[j][2] * v[j][2] + v[j][3] * v[j][3]); }
    s = wave_sum(s); if (lane == 0) *rss = s;
#pragma unroll
    for (int j = 0; j < 8; ++j) { v2u w; w.x = pk2(v[j][0], v[j][1]); w.y = pk2(v[j][2], v[j][3]); *((v2u*)orow + lane + 64 * j) = w; }
}
DI void reduce_phase(Frame& F0, int rsel, bool fin) {
    Frame F = opaque(F0);
    unsigned char* ws = WSB(F); const float* P = (const float*)(ws + WS_PART); float* out = OUTB(F) + (size_t)MP * DM; bf16* XN = (bf16*)(ws + WS_XN) + (size_t)MP * DM; float* rss = (float*)(ws + WS_RSS) + rsel * MT + MP;
    for (int r = F.bid * 8 + F.wave; r < MS; r += F.G * 8) {
        f32x4 v[8]; float s = 0.f;
#pragma unroll
        for (int j = 0; j < 8; ++j) { const v2u w = *((const v2u*)(XN + (size_t)r * DM) + F.lane + 64 * j); v[j] = (f32x4){bflo(w.x), bfhi(w.x), bflo(w.y), bfhi(w.y)}; }
#pragma unroll 1
        for (int sp = 0; sp < NSPLIT; ++sp) {
#pragma unroll
            for (int j = 0; j < 8; ++j) v[j] += *((const f32x4*)(P + ((size_t)sp * MS + r) * DM) + F.lane + 64 * j); }
#pragma unroll
        for (int j = 0; j < 8; ++j) { s += (v[j][0] * v[j][0] + v[j][1] * v[j][1]) + (v[j][2] * v[j][2] + v[j][3] * v[j][3]);
            if (fin) *((f32x4*)(out + (size_t)r * DM) + F.lane + 64 * j) = v[j];
            else { v2u w; w.x = pk2(v[j][0], v[j][1]); w.y = pk2(v[j][2], v[j][3]); *((v2u*)(XN + (size_t)r * DM) + F.lane + 64 * j) = w; } }
        if (!fin) { s = wave_sum(s); if (F.lane == 0) rss[r] = s; }
    }
}
DI void zero_rss(Frame& F0, int rsel) {
    Frame F = opaque(F0); float* rss = (float*)(WSB(F) + WS_RSS) + rsel * MT;
    for (int i = F.bid * 512 + F.tid; i < MP; i += F.G * 512) rss[i] = 0.f;
}
DI void norm_phase(Frame& F0, const float* xp, const float* xs  ) {
    Frame F = opaque(F0);
    bf16* XN = (bf16*)(WSB(F) + WS_XN); float* rss = (float*)(WSB(F) + WS_RSS) + MT;
    for (int m = F.bid * 8 + F.wave; m < MT; m += F.G * 8) xg_row((m < MP ? xp : xs) + (size_t)m * DM, XN + (size_t)m * DM, rss + m, F.lane);
}
DI void convert_weights(Frame& F0, int l, int cu0, int i0, int i1) {
    Frame F = opaque(F0);
    if (F.bid < cu0) return;
    LAS unsigned* scr = (LAS unsigned*)(F.lds + F.wave * 16384);
    const int gw = (F.bid - cu0) * 8 + F.wave, NGW = (F.G - cu0) * 8;
    constexpr int I_IN = (DM / 64) * (NIN / 64), I_O = (DM / 64) * (DM / 64), I_UP = (DM / 64) * (NUP / 64), I_DN = (DFF / 64) * (DM / 64), I_L = I_IN + I_O + I_UP + I_DN;
    for (int it = i0 + gw; it < i1; it += NGW) {
        int r = it;
        if (r < I_IN) { transpose_item<1>(INP(6) + (size_t)l * DM * NIN, INP(5) + l * DM, DM, NIN, (bf16*)(WSB(F) + WS_WIN + l * 13 * MiB), scr, r, F.lane); continue; } r -= I_IN;
        if (r < I_O) { const int k0o = 64 * (r / (DM / 64));
            transpose_item<3>(INP(16) + (size_t)l * DM * DM, k0o < 1024 ? INP(14) + l * 1024 : INP(15) + l * 1024 - 1024, DM, DM, (bf16*)(WSB(F) + WS_WO + l * 8 * MiB), scr, r, F.lane); continue; } r -= I_O;
        if (r < I_UP) { transpose_item<2>(INP(18) + (size_t)l * DM * NUP, INP(17) + l * DM, DM, NUP, (bf16*)(WSB(F) + WS_WUP + l * 43 * MiB), scr, r, F.lane); continue; } r -= I_UP;
        transpose_item<3>(INP(21) + (size_t)l * DFF * DM, nullptr, DFF, DM, (bf16*)(WSB(F) + WS_WDN + l * 22 * MiB), scr, r, F.lane);
    }
    __syncthreads();
}
constexpr int CV_IN = (DM / 64) * (NIN / 64), CV_O = CV_IN + (DM / 64) * (DM / 64), CV_UP = CV_O + (DM / 64) * (NUP / 64), CV_ALL = CV_UP + (DFF / 64) * (DM / 64);
DI void prologue(Frame& F0) {
    convert_weights(F0, 0, 0, 0, CV_O);
    norm_phase(F0, INP(0), INP(1) - (size_t)MP * DM);
}

DI void load_q(bf16x8 (&bq)[4], const bf16* qptr, int hh) {
#pragma unroll
    for (int ks = 0; ks < 4; ++ks) bq[ks] = *(const bf16x8*)(qptr + 16 * ks + 8 * hh);
}
DI float attn_qblock(LAS unsigned char* lds, int kv, int kb0, const bf16x8 (&bq)[4], int distbase, int kimin, float slope2, float sink2, bf16* optr, int lane) {
    const int r = lane & 31, hh = lane >> 5;
    f32x16 s[5];
#pragma unroll
    for (int t = 0; t < 5; ++t) {
#pragma unroll
        for (int i = 0; i < 16; ++i) s[t][i] = 0.f;
#pragma unroll
        for (int ks = 0; ks < 4; ++ks) { const bf16x8 kf = *(const LAS bf16x8*)(lds + KS_OFF + (kv * 192 + 32 * (kb0 + t) + r) * KS_STRIDE + (16 * ks + 8 * hh) * 2); s[t] = MFMA32(kf, bq[ks], s[t]); }
        if (t & 1) __builtin_amdgcn_sched_barrier(0);
    }
    __builtin_amdgcn_sched_barrier(0);
    float mx = sink2;
    int kloi = max(kimin, distbase - 127) - 32 * kb0 - 4 * hh, khii = distbase - 32 * kb0 - 4 * hh;
    asm volatile("" : "+v"(kloi), "+v"(khii));
    const float klof = (float)kloi, khif = (float)khii, base = -slope2 * khif;
#pragma unroll
    for (int t = 0; t < 5; ++t)
#pragma unroll
        for (int i = 0; i < 16; ++i) { const float kkf = (float)(32 * t + crow(i, 0));
            const float x = __builtin_fmaf(slope2, kkf, __builtin_fmaf(s[t][i], 0.125f * LOG2E, base));
            const int msk = __float_as_int(fminf(kkf - klof, khif - kkf)) >> 31;
            const float v = __int_as_float((__float_as_int(x) & ~msk) | (__float_as_int(-1e30f) & msk)); s[t][i] = v; mx = fmaxf(mx, v); }
    mx = fmaxf(mx, __shfl_xor(mx, 32));
    float l = 0.f;
#pragma unroll
    for (int t = 0; t < 5; ++t)
#pragma unroll
        for (int i = 0; i < 16; ++i) { const float p = fexp2(s[t][i] - mx); s[t][i] = p; l += p; }
    l += __shfl_xor(l, 32); l += fexp2(sink2 - mx);
    __builtin_amdgcn_sched_barrier(0);
    f32x16 o[2];
#pragma unroll
    for (int db = 0; db < 2; ++db)
#pragma unroll
        for (int i = 0; i < 16; ++i) o[db][i] = 0.f;
#pragma unroll
    for (int t = 0; t < 5; ++t)
#pragma unroll
        for (int st = 0; st < 2; ++st) {
            v4u pw; pw.x = pk2(s[t][8 * st], s[t][8 * st + 1]); pw.y = pk2(s[t][8 * st + 2], s[t][8 * st + 3]); pw.z = pk2(s[t][8 * st + 4], s[t][8 * st + 5]); pw.w = pk2(s[t][8 * st + 6], s[t][8 * st + 7]);
            const bf16x8 pf = __builtin_bit_cast(bf16x8, pw);
#pragma unroll
            for (int db = 0; db < 2; ++db) { const LAS unsigned char* a = lds + VT_OFF + (kv * 64 + 32 * db + r) * VT_STRIDE + (32 * (kb0 + t) + 16 * st + 4 * hh) * 2;
                const s16x4 lo = *(const LAS s16x4*)a, hi = *(const LAS s16x4*)(a + 16); const bf16x8 vf = __builtin_shufflevector(lo, hi, 0, 1, 2, 3, 4, 5, 6, 7);
                o[db] = MFMA32(vf, pf, o[db]); }
        }
    const float inv = frcp(l); float ssq = 0.f;
#pragma unroll
    for (int db = 0; db < 2; ++db)
#pragma unroll
        for (int g = 0; g < 4; ++g) { const float a0 = o[db][4 * g] * inv, a1 = o[db][4 * g + 1] * inv, a2 = o[db][4 * g + 2] * inv, a3 = o[db][4 * g + 3] * inv;
            ssq += (a0 * a0 + a1 * a1) + (a2 * a2 + a3 * a3); v2u w; w.x = pk2(a0, a1); w.y = pk2(a2, a3); *(v2u*)(optr + 32 * db + 8 * g + 4 * hh) = w; }
    return ssq;
}
DI void put_k(LAS unsigned char* lds, int kv, int ki, int d0, v4u w) { *(LAS v4u*)(lds + KS_OFF + (kv * 192 + ki) * KS_STRIDE + d0 * 2) = w; }
DI void put_v(LAS unsigned char* lds, int kv, int ki, int d0, v4u w) {
    LAS unsigned short* p = (LAS unsigned short*)(lds + VT_OFF + (kv * 64 + d0) * VT_STRIDE + ki * 2);
    p[0 * (VT_STRIDE / 2)] = (unsigned short)(w.x & 0xffff); p[1 * (VT_STRIDE / 2)] = (unsigned short)(w.x >> 16); p[2 * (VT_STRIDE / 2)] = (unsigned short)(w.y & 0xffff); p[3 * (VT_STRIDE / 2)] = (unsigned short)(w.y >> 16);
    p[4 * (VT_STRIDE / 2)] = (unsigned short)(w.z & 0xffff); p[5 * (VT_STRIDE / 2)] = (unsigned short)(w.z >> 16); p[6 * (VT_STRIDE / 2)] = (unsigned short)(w.w & 0xffff); p[7 * (VT_STRIDE / 2)] = (unsigned short)(w.w >> 16);
}
DI void rescale_rows(Frame& F, bf16* MG, int m0, int nrows) {
    LAS float* ST = (LAS float*)(F.lds + ST_OFF);
#pragma unroll 8
    for (int c = F.tid; c < nrows * 256; c += 512) { const int row = c >> 8, cc = (c & 255) * 8; bf16* p = MG + (size_t)(m0 + row) * DM + cc; const v4u raw = *(const v4u*)p;
        const float sc = cc < 1024 ? ST[1280 + row] : ST[1344 + row];
        v4u w; w.x = pk2(bflo(raw.x) * sc, bfhi(raw.x) * sc); w.y = pk2(bflo(raw.y) * sc, bfhi(raw.y) * sc); w.z = pk2(bflo(raw.z) * sc, bfhi(raw.z) * sc); w.w = pk2(bflo(raw.w) * sc, bfhi(raw.w) * sc); *(v4u*)p = w; }
}
DI void mixer_prompt_item(Frame& F0, int l, int item) {
    Frame F = opaque(F0);
    const bf16 *Q = (const bf16*)(WSB(F) + WS_Q), *Kb = (const bf16*)(WSB(F) + WS_K), *Vb = (const bf16*)(WSB(F) + WS_V), *U = (const bf16*)(WSB(F) + WS_U), *VS = (const bf16*)(WSB(F) + WS_VS);
    bf16* MG = (bf16*)(WSB(F) + WS_MG);
    LAS float* ST = (LAS float*)(F.lds + ST_OFF);
    const int b = item >> 5, t0 = (item & 31) * 64, m0 = b * SEQ + t0, tq = t0 & 64, mc = m0 - tq, S = tq + 64;
    const int lane = F.lane, w = F.wave, r = lane & 31, hh = lane >> 5;
    for (int c = F.tid; c < 192 * 16; c += 512) { const int ki = c >> 4, ch = c & 15, kv = ch >> 3, d0 = (ch & 7) * 8; int pos = t0 - 128 + ki; pos = pos < 0 ? 0 : pos;
        const size_t off = (size_t)(b * SEQ + pos) * 128 + kv * 64 + d0; put_k(F.lds, kv, ki, d0, *(const v4u*)(Kb + off)); put_v(F.lds, kv, ki, d0, *(const v4u*)(Vb + off)); }
    __syncthreads();
    for (int rp_ = 0; rp_ < ((MK_MIXDUP & 1) ? 2 : 1); ++rp_)
    {
        const int kv = w >> 2; float sq0 = 0.f, sq1 = 0.f;
        bf16x8 bq[4], bqn[4];
        load_q(bq, Q + (size_t)(m0 + r) * 1024 + (2 * w) * 64, hh);
        const float* sinks = INP(9) + l * 16;
#pragma unroll 1
        for (int it = 0; it < 4; ++it) { const int hs = it >> 1, qb = it & 1; const int h = 2 * w + hs; const float slope2 = fexp2(-0.5f * (float)(h + 1)) * LOG2E, sink2 = sinks[h] * LOG2E;
            const int row = m0 + 32 * qb + r;
            load_q(bq, Q + (size_t)row * 1024 + h * 64, hh);
            float s = attn_qblock(F.lds, kv, qb, bq, 32 * qb + r + 128, 128 - t0, slope2, sink2, MG + (size_t)row * DM + h * 64, lane);
            s += __shfl_xor(s, 32); sq0 += qb == 0 ? s : 0.f; sq1 += qb == 1 ? s : 0.f;
}
        if (hh == 0) { ST[w * 64 + r] = sq0; ST[w * 64 + 32 + r] = sq1; }
    }
    __syncthreads();
#pragma unroll 1
    for (int rq_ = 0; rq_ < ((MK_MIXDUP & 2) ? 2 : 1); ++rq_) {
    for (int sb = w; sb < S; sb += 32) {
        v4u a[4], c[4];
#pragma unroll
        for (int k = 0; k < 4; ++k) { const bf16* p = VS + (size_t)(mc + sb + 8 * k) * 1024 + 8 * lane; a[k] = *(const v4u*)p; c[k] = *(const v4u*)(p + 512); }
#pragma unroll
        for (int k = 0; k < 4; ++k) {
            const float x[16] = {bflo(a[k].x), bfhi(a[k].x), bflo(a[k].y), bfhi(a[k].y), bflo(a[k].z), bfhi(a[k].z), bflo(a[k].w), bfhi(a[k].w), bflo(c[k].x), bfhi(c[k].x), bflo(c[k].y), bfhi(c[k].y), bflo(c[k].z), bfhi(c[k].z), bflo(c[k].w), bfhi(c[k].w)};
            float sm = 0.f, s2 = 0.f;
#pragma unroll
            for (int j = 0; j < 16; ++j) { sm += x[j]; s2 += x[j] * x[j]; }
            sm = wave_sum(sm); s2 = wave_sum(s2); const float mu = sm * (1.0f / 1024.0f), var = s2 * (1.0f / 1024.0f) - mu * mu;
            if (lane == 0) { ST[1024 + sb + 8 * k] = mu; ST[1152 + sb + 8 * k] = frsq(fmaxf(var, 0.f) + EPS); } } }
    __syncthreads();
    {
        const int h = w; LAS unsigned char* vst = F.lds + w * SG_WAVE;
        const float* lng = INP(10) + l * 1024 + h * 128; const float* lnb = INP(11) + l * 1024 + h * 128;
        const float* Wl = INP(12) + (size_t)(l * 8 + h) * 128 * 128; const float* bsl = INP(13) + (l * 8 + h) * 128;
        float sq0 = 0.f, sq1 = 0.f;
        bf16x8 wf[2][8];
#pragma unroll
        for (int tb = 0; tb < 2; ++tb) { const int t = tq + 32 * tb + r, nks = (tq + 32 * tb + 32) >> 4;
#pragma unroll
            for (int ks = 0; ks < 8; ++ks) { v4u bw = (v4u){0u, 0u, 0u, 0u};
                if (ks < nks) { const int s0 = 16 * ks + 8 * hh; const float* wp = Wl + (size_t)t * 128 + s0; const f32x4 w0 = *(const f32x4*)wp, w1 = *(const f32x4*)(wp + 4);
                    bw.x = pk2(s0 <= t ? w0[0] : 0.f, s0 + 1 <= t ? w0[1] : 0.f); bw.y = pk2(s0 + 2 <= t ? w0[2] : 0.f, s0 + 3 <= t ? w0[3] : 0.f);
                    bw.z = pk2(s0 + 4 <= t ? w1[0] : 0.f, s0 + 5 <= t ? w1[1] : 0.f); bw.w = pk2(s0 + 6 <= t ? w1[2] : 0.f, s0 + 7 <= t ? w1[3] : 0.f); }
                wf[tb][ks] = __builtin_bit_cast(bf16x8, bw); } }
        const int nch = S * 4;
#pragma unroll 1
        for (int eq = 0; eq < 4; ++eq) {
            { const int e0 = (lane & 3) * 8; const f32x4 g0 = *(const f32x4*)(lng + 32 * eq + e0), g1 = *(const f32x4*)(lng + 32 * eq + e0 + 4), b0 = *(const f32x4*)(lnb + 32 * eq + e0), b1 = *(const f32x4*)(lnb + 32 * eq + e0 + 4);
#pragma unroll 1
            for (int ib = 0; ib < nch; ib += 256) {
                v4u raw[4];
#pragma unroll
                for (int i = 0; i < 4; ++i) { const int c = ib + lane + 64 * i; raw[i] = *(const v4u*)(VS + (size_t)(mc + (c >> 2)) * 1024 + h * 128 + 32 * eq + (c & 3) * 8); }
#pragma unroll
                for (int i = 0; i < 4; ++i) { const int c = ib + lane + 64 * i; const int s = c >> 2; const float mu = ST[1024 + s], rs = ST[1152 + s]; const v4u rw = raw[i];
                    const unsigned y01 = pk2((bflo(rw.x) - mu) * rs * g0[0] + b0[0], (bfhi(rw.x) - mu) * rs * g0[1] + b0[1]), y23 = pk2((bflo(rw.y) - mu) * rs * g0[2] + b0[2], (bfhi(rw.y) - mu) * rs * g0[3] + b0[3]);
                    const unsigned y45 = pk2((bflo(rw.z) - mu) * rs * g1[0] + b1[0], (bfhi(rw.z) - mu) * rs * g1[1] + b1[1]), y67 = pk2((bflo(rw.w) - mu) * rs * g1[2] + b1[2], (bfhi(rw.w) - mu) * rs * g1[3] + b1[3]);
                    LAS unsigned short* p = (LAS unsigned short*)(vst + e0 * 272 + s * 2);
                    p[0] = (unsigned short)(y01 & 0xffff); p[136] = (unsigned short)(y01 >> 16); p[272] = (unsigned short)(y23 & 0xffff); p[408] = (unsigned short)(y23 >> 16);
                    p[544] = (unsigned short)(y45 & 0xffff); p[680] = (unsigned short)(y45 >> 16); p[816] = (unsigned short)(y67 & 0xffff); p[952] = (unsigned short)(y67 >> 16); } } }
            LDS_WAIT();
#pragma unroll
            for (int tb = 0; tb < 2; ++tb) {
                const int t = tq + 32 * tb + r, nks = (tq + 32 * tb + 32) >> 4;
                const float bs = bsl[t]; const size_t row = (size_t)(mc + t);
                v2u ur[4];
#pragma unroll
                for (int g = 0; g < 4; ++g) ur[g] = *(const v2u*)(U + row * 1024 + h * 128 + 32 * eq + 8 * g + 4 * hh);
                f32x16 acc;
#pragma unroll
                for (int i = 0; i < 16; ++i) acc[i] = 0.f;
#pragma unroll
                for (int ks = 0; ks < 8; ++ks) if (ks < nks) { const bf16x8 af = *(const LAS bf16x8*)(vst + r * 272 + (16 * ks + 8 * hh) * 2); acc = MFMA32(af, wf[tb][ks], acc); }
                float ss = 0.f;
#pragma unroll
                for (int g = 0; g < 4; ++g) { const int e = 32 * eq + 8 * g + 4 * hh;
                    const float a0 = (acc[4 * g] + bs) * bflo(ur[g].x), a1 = (acc[4 * g + 1] + bs) * bfhi(ur[g].x), a2 = (acc[4 * g + 2] + bs) * bflo(ur[g].y), a3 = (acc[4 * g + 3] + bs) * bfhi(ur[g].y);
                    ss += (a0 * a0 + a1 * a1) + (a2 * a2 + a3 * a3); v2u o; o.x = pk2(a0, a1); o.y = pk2(a2, a3); *(v2u*)(MG + row * DM + 1024 + h * 128 + e) = o; }
                ss += __shfl_xor(ss, 32); if (tb == 0) sq0 += ss; else sq1 += ss;
            }
            LDS_WAIT();
        }
        if (hh == 0) { ST[512 + w * 64 + r] = sq0; ST[512 + w * 64 + 32 + r] = sq1; }
    }
    __syncthreads();
    }
    if (F.tid < 64) { float a = 0.f, s = 0.f;
#pragma unroll
        for (int k = 0; k < 8; ++k) { a += ST[k * 64 + F.tid]; s += ST[512 + k * 64 + F.tid]; }
        ST[1280 + F.tid] = frsq(a * (1.0f / 1024.0f) + EPS); ST[1344 + F.tid] = frsq(s * (1.0f / 1024.0f) + EPS); }
    __syncthreads();
    rescale_rows(F, MG, m0, 64);
    __syncthreads();
}
DI void mixer_sample_item(Frame& F0, int l, int seq) {
    Frame F = opaque(F0);
    const bf16 *Q = (const bf16*)(WSB(F) + WS_Q), *Kb = (const bf16*)(WSB(F) + WS_K), *Vb = (const bf16*)(WSB(F) + WS_V), *U = (const bf16*)(WSB(F) + WS_U), *VS = (const bf16*)(WSB(F) + WS_VS);
    bf16* MG = (bf16*)(WSB(F) + WS_MG);
    LAS float* ST = (LAS float*)(F.lds + ST_OFF);
    const int lane = F.lane, w = F.wave, m0 = MP + seq * 4;
    const float* ck = INP(2) + (size_t)(l * 128 + seq) * 128 * 128; const float* cv = INP(3) + (size_t)(l * 128 + seq) * 128 * 128;
    float* okw = OUTB(F) + O_KS + (size_t)(l * 128 + seq) * 128 * 128; float* ovw = OUTB(F) + O_VSO + (size_t)(l * 128 + seq) * 128 * 128;
    if (F.tid < 8) ST[F.tid] = 0.f;
    for (int c = F.tid; c < 160 * 16; c += 512) { const int ki = c >> 4, ch = c & 15, kv = ch >> 3, d0 = (ch & 7) * 8; v4u kw, vw;
        if (ki < 128) { const float* kp = ck + (size_t)ki * 128 + kv * 64 + d0; const float* vp = cv + (size_t)ki * 128 + kv * 64 + d0;
            const f32x4 k0 = *(const f32x4*)kp, k1 = *(const f32x4*)(kp + 4), v0 = *(const f32x4*)vp, v1 = *(const f32x4*)(vp + 4);
            if (ki >= 4) { float* ok = okw + (size_t)(ki - 4) * 128 + kv * 64 + d0; float* ov = ovw + (size_t)(ki - 4) * 128 + kv * 64 + d0; *(f32x4*)ok = k0; *(f32x4*)(ok + 4) = k1; *(f32x4*)ov = v0; *(f32x4*)(ov + 4) = v1; }
            kw.x = pk2(k0[0], k0[1]); kw.y = pk2(k0[2], k0[3]); kw.z = pk2(k1[0], k1[1]); kw.w = pk2(k1[2], k1[3]); vw.x = pk2(v0[0], v0[1]); vw.y = pk2(v0[2], v0[3]); vw.z = pk2(v1[0], v1[1]); vw.w = pk2(v1[2], v1[3]);
        } else if (ki < 132) { const size_t off = (size_t)(m0 + ki - 128) * 128 + kv * 64 + d0; kw = *(const v4u*)(Kb + off); vw = *(const v4u*)(Vb + off); }
        else { kw = (v4u){0u, 0u, 0u, 0u}; vw = kw; }
        put_k(F.lds, kv, ki, d0, kw); put_v(F.lds, kv, ki, d0, vw); }
    __syncthreads();
    if (w < 2) { const int kv = w, j = lane & 31, t = j >> 3, h = kv * 8 + (j & 7), row = m0 + t; const float slope2 = fexp2(-0.5f * (float)(h + 1)) * LOG2E, sink2 = INP(9)[l * 16 + h] * LOG2E;
        bf16x8 bq[4]; load_q(bq, Q + (size_t)row * 1024 + h * 64, lane >> 5);
        float s = attn_qblock(F.lds, kv, 0, bq, 128 + t, 0, slope2, sink2, MG + (size_t)row * DM + h * 64, lane);
        atomicAdd((float*)(ST + t), s); }
    __syncthreads();
    LAS float* VN = (LAS float*)F.lds;
    if (w < 4) { const bf16* p = VS + (size_t)(m0 + w) * 1024 + 8 * lane; const v4u a = *(const v4u*)p, c = *(const v4u*)(p + 512);
        float x[16] = {bflo(a.x), bfhi(a.x), bflo(a.y), bfhi(a.y), bflo(a.z), bfhi(a.z), bflo(a.w), bfhi(a.w), bflo(c.x), bfhi(c.x), bflo(c.y), bfhi(c.y), bflo(c.z), bfhi(c.z), bflo(c.w), bfhi(c.w)};
        float sm = 0.f, s2 = 0.f;
#pragma unroll
        for (int j = 0; j < 16; ++j) { sm += x[j]; s2 += x[j] * x[j]; }
        sm = wave_sum(sm); s2 = wave_sum(s2); const float mu = sm * (1.0f / 1024.0f), rs = frsq(fmaxf(s2 * (1.0f / 1024.0f) - mu * mu, 0.f) + EPS);
        const float* lng = INP(10) + l * 1024; const float* lnb = INP(11) + l * 1024; float* osv = OUTB(F) + O_SV + (size_t)((l * 128 + seq) * 4 + w) * 1024;
#pragma unroll
        for (int hf = 0; hf < 2; ++hf) { const int c0 = 512 * hf + 8 * lane;
#pragma unroll
            for (int q4 = 0; q4 < 2; ++q4) { const f32x4 g = *(const f32x4*)(lng + c0 + 4 * q4), bb = *(const f32x4*)(lnb + c0 + 4 * q4); f32x4 y;
#pragma unroll
                for (int e = 0; e < 4; ++e) y[e] = (x[8 * hf + 4 * q4 + e] - mu) * rs * g[e] + bb[e];
                *(f32x4*)(osv + c0 + 4 * q4) = y; *(LAS f32x4*)(VN + w * 1024 + c0 + 4 * q4) = y; } } }
    __syncthreads();
    { const int t = F.tid >> 7, c0 = (F.tid & 127) * 8, h = c0 >> 7; const float* Wr = INP(12) + ((size_t)(l * 8 + h) * 128 + t) * 128; const float bs = INP(13)[(l * 8 + h) * 128 + t];
        const v4u ur = *(const v4u*)(U + (size_t)(m0 + t) * 1024 + c0); const float uu[8] = {bflo(ur.x), bfhi(ur.x), bflo(ur.y), bfhi(ur.y), bflo(ur.z), bfhi(ur.z), bflo(ur.w), bfhi(ur.w)};
        float o[8]; float ss = 0.f;
#pragma unroll
        for (int j = 0; j < 8; ++j) { float mix = bs;
#pragma unroll
            for (int s = 0; s < 4; ++s) mix += (s <= t ? Wr[s] : 0.f) * VN[s * 1024 + c0 + j];
            o[j] = uu[j] * mix; ss += o[j] * o[j]; }
        v4u wv; wv.x = pk2(o[0], o[1]); wv.y = pk2(o[2], o[3]); wv.z = pk2(o[4], o[5]); wv.w = pk2(o[6], o[7]); *(v4u*)(MG + (size_t)(m0 + t) * DM + 1024 + c0) = wv;
        ss = wave_sum(ss); if (lane == 0) atomicAdd((float*)(ST + 4 + t), ss); }
    __syncthreads();
    if (F.tid < 4) { ST[1280 + F.tid] = frsq(ST[F.tid] * (1.0f / 1024.0f) + EPS); ST[1344 + F.tid] = frsq(ST[4 + F.tid] * (1.0f / 1024.0f) + EPS); }
    __syncthreads();
    rescale_rows(F, MG, m0, 4);
    __syncthreads();
}
DI void mixer_phase(Frame& F0, int l) {
    Frame F = opaque(F0);
    if (l == 0) convert_weights(F0, 0, (256 + 128) % F.G, CV_UP, CV_ALL);
    for (int it = F.bid; it < 256 + 128; it += F.G) { if (it < 256) { if (PHEN(8)) mixer_prompt_item(F, l, it); } else { if (PHEN(9)) mixer_sample_item(F, l, it - 256); } }
}
DI void fix_phase(Frame& F0, int l) {
    Frame F = opaque(F0);
    bf16* ACT = (bf16*)(WSB(F) + WS_ACT); const float* BND = (const float*)(WSB(F) + WS_BND); const float* HS = (const float*)(WSB(F) + WS_HS);
    const float* cw = INP(19) + (size_t)l * 3 * NUP; const float* cb = INP(20) + (size_t)l * NUP; const float* stin = INP(4) + (size_t)l * 128 * 2 * NUP; float* outb = OUTB(F);
    const int gt = F.bid * 512 + F.tid, NT = F.G * 512;
    constexpr int CQ = DFF / 4;
    constexpr int NA = CQ * 64, NC = CQ * 32;
    for (int i = gt; i < NA + NC; i += NT) {
        const bool smp = i >= NA; const int j = smp ? i - NA : i, cq = j % CQ, grp = j / CQ, c = cq * 4;
        f32x4 w0[2], w1[2], w2[2], bb[2];
#pragma unroll
        for (int part = 0; part < 2; ++part) { const int cc = part * DFF + c; w0[part] = *(const f32x4*)(cw + cc); w1[part] = *(const f32x4*)(cw + NUP + cc); w2[part] = *(const f32x4*)(cw + 2 * NUP + cc); bb[part] = *(const f32x4*)(cb + cc); }
        if (!smp) {
#pragma unroll 2
            for (int k = 0; k < 4; ++k) { const int blk = grp * 4 + k; const bool first = (blk & 31) == 0; f32x4 act0, act1;
#pragma unroll
                for (int part = 0; part < 2; ++part) { const int cc = part * DFF + c; const f32x4 z = (f32x4){0.f, 0.f, 0.f, 0.f};
                    const float* cur = BND + (size_t)blk * 4 * NUP + cc; const float* prv = cur - (size_t)4 * NUP;
                    const f32x4 h0 = *(const f32x4*)cur, h1 = *(const f32x4*)(cur + NUP), hm2 = first ? z : *(const f32x4*)(prv + 2 * NUP), hm1 = first ? z : *(const f32x4*)(prv + 3 * NUP);
                    const f32x4 r0 = bb[part] + w0[part] * hm2 + w1[part] * hm1 + w2[part] * h0, r1 = bb[part] + w0[part] * hm1 + w1[part] * h0 + w2[part] * h1;
                    if (part == 0) { act0 = r0; act1 = r1; } else {
#pragma unroll
                        for (int e = 0; e < 4; ++e) { act0[e] *= silu(r0[e]); act1[e] *= silu(r1[e]); } } }
                v2u w; w.x = pk2(act0[0], act0[1]); w.y = pk2(act0[2], act0[3]); *(v2u*)(ACT + (size_t)(blk * 64) * DFF + c) = w;
                w.x = pk2(act1[0], act1[1]); w.y = pk2(act1[2], act1[3]); *(v2u*)(ACT + (size_t)(blk * 64 + 1) * DFF + c) = w; }
        } else {
#pragma unroll 1
            for (int k = 0; k < 4; ++k) { const int seq = grp * 4 + k; f32x4 act[4];
#pragma unroll
                for (int part = 0; part < 2; ++part) { const int cc = part * DFF + c; const float* st = stin + (size_t)seq * 2 * NUP + cc; const float* hs = HS + (size_t)seq * 4 * NUP + cc;
                    f32x4 hp[6]; hp[0] = *(const f32x4*)st; hp[1] = *(const f32x4*)(st + NUP);
#pragma unroll
                    for (int t = 0; t < 4; ++t) hp[2 + t] = *(const f32x4*)(hs + (size_t)t * NUP);
                    float* oc = outb + O_CS + (size_t)(l * 128 + seq) * 2 * NUP + cc; *(f32x4*)oc = hp[4]; *(f32x4*)(oc + NUP) = hp[5];
#pragma unroll
                    for (int t = 0; t < 4; ++t) { const f32x4 hc = bb[part] + w0[part] * hp[t] + w1[part] * hp[t + 1] + w2[part] * hp[t + 2];
                        if (part == 0) act[t] = hc; else {
#pragma unroll
                            for (int e = 0; e < 4; ++e) act[t][e] *= silu(hc[e]); } } }
#pragma unroll
                for (int t = 0; t < 4; ++t) { v2u w; w.x = pk2(act[t][0], act[t][1]); w.y = pk2(act[t][2], act[t][3]); *(v2u*)(ACT + (size_t)(MP + seq * 4 + t) * DFF + c) = w; } }
        }
    }
    for (int i = gt; i < 8 * 2 * (NUP / 4); i += NT) { const int cq = i % (NUP / 4), rr = (i / (NUP / 4)) & 1, b = i / (2 * (NUP / 4));
        *(f32x4*)(outb + O_CP + ((size_t)(l * 8 + b) * 2 + rr) * NUP + cq * 4) = *(const f32x4*)(BND + ((size_t)(b * 32 + 31) * 4 + 2 + rr) * NUP + cq * 4); }
}

#define XB_TMO      128
#define XB_XCNT(j)  (256  + 64 * (j))
#define XB_XSUB(j)  (1280 + 64 * (j))
#define XB_XGEN(j)  (2304 + 64 * (j))
#define XB_TOP      3328
#define XB_TOPGEN   3392
#define XCD_BAR_WORDS 3456
#define XB_SPIN_CAP (1u << 18)

__device__ __forceinline__ unsigned xb_ld(unsigned* p)              { return __hip_atomic_load(p, __ATOMIC_RELAXED, __HIP_MEMORY_SCOPE_AGENT); }
__device__ __forceinline__ unsigned xb_add(unsigned* p, unsigned v) { return __hip_atomic_fetch_add(p, v, __ATOMIC_RELAXED, __HIP_MEMORY_SCOPE_AGENT); }
__device__ __forceinline__ unsigned xb_xcc_id() { return (unsigned)__builtin_amdgcn_s_getreg((3 << 11) | 20) & 0xFu; }
#define XB_SPIN(cond, bar) do { unsigned _sp = 0; while (cond) { __builtin_amdgcn_s_sleep(1); \
    if ((++_sp & 255u) == 0u) { if (xb_ld(&(bar)[XB_TMO])) break; if (_sp > XB_SPIN_CAP) { atomicAdd(&(bar)[XB_TMO], 1u); break; } } } } while (0)

struct XcdBarrier {
    unsigned* bar; unsigned x;
    volatile LAS unsigned* st;
};

__device__ __forceinline__ XcdBarrier xcd_barrier_post(unsigned* bar, volatile LAS unsigned* st) {
    XcdBarrier b; b.bar = bar; b.x = xb_xcc_id(); b.st = st;
    if (threadIdx.x == 0) (void)xb_add(&bar[XB_XCNT(b.x)], 1u);
    return b;
}
__device__ __forceinline__ void xcd_barrier_complete(unsigned* bar, unsigned x, unsigned& nloc, unsigned& nx) {
    const unsigned G = gridDim.x * gridDim.y * gridDim.z;
    unsigned sum, cnt, mine, sp = 0u;
    for (;;) {
        sum = 0u; cnt = 0u; mine = 0u;
#pragma unroll
        for (unsigned j = 0; j < 16; ++j) { const unsigned c = xb_ld(&bar[XB_XCNT(j)]); sum += c; cnt += (c > 0u) ? 1u : 0u; mine = (j == x) ? c : mine; }
        if (sum == G) break;
        __builtin_amdgcn_s_sleep(1);
        if ((++sp & 255u) == 0u) { if (xb_ld(&bar[XB_TMO])) break; if (sp > XB_SPIN_CAP) { atomicAdd(&bar[XB_TMO], 1u); break; } }
    }
    nloc = mine > 0u ? mine : 1u; nx = cnt > 0u ? cnt : 1u;
}

__device__ __forceinline__ void xcd_barrier(const XcdBarrier& b) {
    asm volatile("s_waitcnt vmcnt(0)" ::: "memory");
    __syncthreads();
    if (threadIdx.x == 0) {
        unsigned* bar = b.bar;
        __builtin_amdgcn_s_waitcnt(0);
        unsigned nloc = b.st[0], nx = b.st[1];
        if (nloc == 0u) { xcd_barrier_complete(bar, b.x, nloc, nx); b.st[0] = nloc; b.st[1] = nx; }
        const unsigned old = xb_add(&bar[XB_XSUB(b.x)], 1u);
        const unsigned gen = old / nloc;
        if (old + 1u == (gen + 1u) * nloc) {
            __builtin_amdgcn_fence(__ATOMIC_RELEASE, "agent");
            asm volatile("s_waitcnt vmcnt(0)" ::: "memory");
            const unsigned og = xb_add(&bar[XB_TOP], 1u);
            const unsigned tg = og / nx;
            if (og + 1u == (tg + 1u) * nx) xb_add(&bar[XB_TOPGEN], 1u);
            else XB_SPIN(xb_ld(&bar[XB_TOPGEN]) == tg, bar);
            __builtin_amdgcn_fence(__ATOMIC_ACQUIRE, "agent");
            xb_add(&bar[XB_XGEN(b.x)], 1u);
            asm volatile("s_waitcnt vmcnt(0)" ::: "memory");
        } else {
            XB_SPIN(xb_ld(&bar[XB_XGEN(b.x)]) == gen, bar);
            __builtin_amdgcn_fence(__ATOMIC_ACQUIRE, "agent");
            asm volatile("s_waitcnt vmcnt(0)" ::: "memory");
        }
    }
    __syncthreads();
}

__global__ void __launch_bounds__(512, 2) mk_fwd(Args args) {
    extern __shared__ __attribute__((aligned(16))) unsigned char lds[];
    Frame F;
    F.lds = (LAS unsigned char*)lds; F.tid = 0; F.lane = 0; F.wave = __builtin_amdgcn_readfirstlane((int)threadIdx.x >> 6); F.G = gridDim.x; F.bid = blockIdx.x;
    F.out = args.out; F.ws = args.ws;
    const int lo = args.ph_lo, hi = args.ph_hi;
    volatile LAS unsigned* bst = (volatile LAS unsigned*)(F.lds + LDS_BYTES - 64);
    if (threadIdx.x < 16) bst[threadIdx.x] = 0u;
    __syncthreads();
    (void)xcd_barrier_post((unsigned*)(args.ws) + CW_BAR, bst);
#define IN(k) (lo <= (k) && (k) < hi)
#define SEAMX() do { XcdBarrier b_; b_.bar = (unsigned*)WSB(F) + CW_BAR; b_.x = xb_xcc_id(); b_.st = (volatile LAS unsigned*)(F.lds + LDS_BYTES - 64); xcd_barrier(b_); } while (0)
#define SEAM(k) do { if (IN(k) && IN((k) + 1)) { if ((k) == 0) cg::this_grid().sync(); else { XcdBarrier b_; b_.bar = (unsigned*)WSB(F) + CW_BAR; b_.x = xb_xcc_id(); b_.st = (volatile LAS unsigned*)(F.lds + LDS_BYTES - 64); xcd_barrier(b_); } } } while (0)
    if (PHEN(0) && IN(0)) { prologue(F); } SEAM(0);
#ifdef MK_XSYNC
#pragma unroll 1
    for (int xs_ = 0; xs_ < MK_XSYNC; ++xs_) cg::this_grid().sync();
#endif
#pragma unroll 1
    for (int l = 0; l < DEPTH; ++l) {
        const int p0 = 1 + 8 * l;
        if (PHEN(1) && IN(p0)) {
            zero_rss(F, 0);
            pg8::Gemm g{(const bf16*)(WSB(F) + WS_XN), (const bf16*)(WSB(F) + WS_WIN + l * 13 * MiB), MT, NIN, DM, F.wave}; pg8::StaticOrder S; S.init(MT, NIN, F.G, F.bid, DM / 64);
            EpiIn E{WSB(F), OUTB(F), l};
            pg8::gemm_phase<EpiIn, pg8::StaticOrder, true, true>(F.lds, g, S, E);
            if (l == 0) convert_weights(F, 0, ((MT / 256) * (NIN / 256)) % F.G, CV_O, CV_UP);
        } SEAM(p0);
        if (PHEN(2) && IN(p0 + 1)) { mixer_phase(F, l); } SEAM(p0 + 1);
        if (PHEN(3) && IN(p0 + 2)) {
            pg8::Gemm g{(const bf16*)(WSB(F) + WS_MG), (const bf16*)(WSB(F) + WS_WO + l * 8 * MiB), MT, DM, DM, F.wave}; pg8::SplitOrder S; S.init(MP, MS, DM, F.G, F.bid, DM / 64, NSPLIT);
            EpiRes E{OUTB(F), WSB(F), 0, false};
            pg8::gemm_phase<EpiRes, pg8::SplitOrder, true, true>(F.lds, g, S, E);
        } SEAM(p0 + 2);
        if (PHEN(4) && IN(p0 + 3)) { reduce_phase(F, 0, false); } SEAM(p0 + 3);
        if (PHEN(5) && IN(p0 + 4)) {
            zero_rss(F, 1);
            pg8::Gemm g{(const bf16*)(WSB(F) + WS_XN), (const bf16*)(WSB(F) + WS_WUP + l * 43 * MiB), MT, NUP, DM, F.wave}; pg8::StaticOrder S; S.init(MT, NUP, F.G, F.bid, DM / 64);
            EpiUp E{WSB(F), l};
            pg8::gemm_phase<EpiUp, pg8::StaticOrder, true, true>(F.lds, g, S, E);
            if (l == 0) convert_weights(F, 1, ((MT / 256) * (NUP / 256)) % F.G, 0, CV_ALL);
        } SEAM(p0 + 4);
        if (PHEN(6) && IN(p0 + 5)) { fix_phase(F, l); } SEAM(p0 + 5);
        if (PHEN(7) && IN(p0 + 6)) {
            pg8::Gemm g{(const bf16*)(WSB(F) + WS_ACT), (const bf16*)(WSB(F) + WS_WDN + l * 22 * MiB), MT, DM, DFF, F.wave}; pg8::SplitOrder S; S.init(MP, MS, DM, F.G, F.bid, DFF / 64, NSPLIT);
            EpiRes E{OUTB(F), WSB(F), 1, l + 1 == DEPTH};
            pg8::gemm_phase<EpiRes, pg8::SplitOrder, true, true>(F.lds, g, S, E);
        } SEAM(p0 + 6);
        if (PHEN(4) && IN(p0 + 7)) { reduce_phase(F, 1, l + 1 == DEPTH); } SEAM(p0 + 7);
    }
#undef IN
#undef SEAM
}

extern "C" void kernel_launch(void* const* d_in, const int* in_sizes, int n_in, void* d_out, int out_size, void* d_ws, size_t ws_size, hipStream_t stream) {
    static int grid = 0;
    if (grid == 0) {
        if (n_in != 22 || (size_t)out_size != O_END || ws_size < WS_END) { fprintf(stderr, "kernel_launch: unexpected shapes (n_in %d out %d ws %zu)\n", n_in, out_size, ws_size); grid = -1; return; }
        if (hipFuncSetAttribute((const void*)mk_fwd, hipFuncAttributeMaxDynamicSharedMemorySize, LDS_BYTES) != hipSuccess) { fprintf(stderr, "hipFuncSetAttribute failed\n"); grid = -1; return; }
        int dev = 0, cus = 0, per_cu = 0;
        (void)hipGetDevice(&dev); (void)hipDeviceGetAttribute(&cus, hipDeviceAttributeMultiprocessorCount, dev);
        (void)hipOccupancyMaxActiveBlocksPerMultiprocessor(&per_cu, (const void*)mk_fwd, 512, LDS_BYTES);
        if (per_cu < 1) per_cu = 1;
        grid = cus > 0 ? cus : 256;
        (void)hipGetLastError();
    }
    if (grid < 0) return;
    if (hipMemsetAsync(d_ws, 0, 65536, stream) != hipSuccess) { fprintf(stderr, "memset failed\n"); return; }
    Args a{};
    for (int i = 0; i < 22; ++i) a.in[i] = (const float*)d_in[i];
    a.out = (float*)d_out; a.ws = (unsigned char*)d_ws;
    for (int t = 0; t < 8; ++t) a.rep[t] = 1 + (((MK_DUP) >> t) & 1) * (t == 7 ? 2 : 1);
    constexpr int NL = MK_N_LAUNCHES;
    if (NL == 1) {
        a.ph_lo = 0; a.ph_hi = 1 + 8 * DEPTH;
        void* kargs[] = {&a};
        hipError_t e = hipLaunchCooperativeKernel((const void*)mk_fwd, dim3(grid), dim3(512), kargs, LDS_BYTES, stream);
        if (e != hipSuccess) fprintf(stderr, "cooperative launch failed: %s (grid %d)\n", hipGetErrorString(e), grid);
    } else {
        for (int p = 0; p < 1 + 8 * DEPTH; ++p) { if (p == 8 * DEPTH) break;
            a.ph_lo = p; a.ph_hi = p + 1;
            hipLaunchKernelGGL(mk_fwd, dim3(grid), dim3(512), LDS_BYTES, stream, a); }
    }
}
```
